# Optimizing an MI355X kernel written in HIP

```python
import jax, jax.numpy as jnp
from jax import lax
import numpy as np

D_MODEL = 1024
BATCH = 32
SEQ = 256
DEPTH = 1
DEC_BATCH = 2
DEC_SEQ = 4096
PAST_LEN = 256

GRID_W = 64
N_HEADS = 8
N_KV_HEADS = 2
HEAD_DIM = 128
Q_GROUP = N_HEADS // N_KV_HEADS
WINDOW = 128
BLOCK = 128
D_GMLP = 1024
GMLP_GROUPS = 8
GMLP_GROUP_DIM = D_GMLP // GMLP_GROUPS
CHUNK = 128
D_FF = 2816
CONV_WIDTH = 3
ROPE_THETA = 10000.0
EPS = 1e-6
NEG_INF = -1e30
SCALE = HEAD_DIM ** -0.5
D_Q = N_HEADS * HEAD_DIM
D_KV = N_KV_HEADS * HEAD_DIM
D_IN = D_Q + 2 * D_KV + 2 * D_GMLP + 2 * D_MODEL

kernel_name = "hybrid_gmlp_swa_prefix_dit_step"


def rmsnorm(x, g):
    xf = x.astype(jnp.float32)
    xf = xf * lax.rsqrt(jnp.mean(xf * xf, axis=-1, keepdims=True) + EPS)
    return (xf * g.astype(jnp.float32)).astype(x.dtype)


def adaln(cvec, w_ada, b_ada):
    m = jax.nn.silu(cvec) @ w_ada + b_ada
    return jnp.split(m, 6, axis=-1)


def modulate(xn, shift, scale):
    return xn * (1 + scale) + shift


def axial_angles(T):
    rows = T // GRID_W
    row = jnp.repeat(jnp.arange(rows, dtype=jnp.float32), GRID_W)
    col = jnp.tile(jnp.arange(GRID_W, dtype=jnp.float32), rows)
    n_freq = HEAD_DIM // 4
    inv = ROPE_THETA ** (-jnp.arange(n_freq, dtype=jnp.float32) / n_freq)
    return row[:, None] * inv[None, :], col[:, None] * inv[None, :]


def rope_half(x, ang):
    x1, x2 = jnp.split(x, 2, axis=-1)
    cos = jnp.cos(ang)[None, :, None, :].astype(x.dtype)
    sin = jnp.sin(ang)[None, :, None, :].astype(x.dtype)
    return jnp.concatenate([x1 * cos - x2 * sin, x1 * sin + x2 * cos], axis=-1)


def apply_rope_2d(x, ang_r, ang_c):
    xr, xc = jnp.split(x, 2, axis=-1)
    return jnp.concatenate([rope_half(xr, ang_r), rope_half(xc, ang_c)], axis=-1)


def context_attention(q, k, v, sink):
    B, S = q.shape[0], q.shape[1]
    n = S // BLOCK
    qb = q.reshape(B, n, BLOCK, N_KV_HEADS, Q_GROUP, HEAD_DIM).transpose(1, 0, 2, 3, 4, 5)
    sink_l = sink.reshape(N_KV_HEADS, Q_GROUP).astype(jnp.float32)

    def one_block(qblk):
        s = jnp.einsum('bqkgd,bskd->bkgqs', qblk, k).astype(jnp.float32) * SCALE
        sk = jnp.broadcast_to(sink_l[None, :, :, None, None], s.shape[:-1] + (1,))
        p = jax.nn.softmax(jnp.concatenate([s, sk], axis=-1), axis=-1)[..., :S].astype(v.dtype)
        return jnp.einsum('bkgqs,bskd->bqkgd', p, v)

    o = lax.map(one_block, qb)
    return o.transpose(1, 0, 2, 3, 4, 5).reshape(B, S, D_Q)


def latent_attention(q, k, v, k_ctx, v_ctx, sink):
    B, T = q.shape[0], q.shape[1]
    n = T // BLOCK
    P = k_ctx.shape[1]
    qb = q.reshape(B, n, BLOCK, N_KV_HEADS, Q_GROUP, HEAD_DIM)
    kb = k.reshape(B, n, BLOCK, N_KV_HEADS, HEAD_DIM)
    vb = v.reshape(B, n, BLOCK, N_KV_HEADS, HEAD_DIM)

    def band(xb):
        xp = jnp.pad(xb, ((0, 0), (1, 1), (0, 0), (0, 0), (0, 0)))
        return jnp.concatenate([xp[:, :-2], xp[:, 1:-1], xp[:, 2:]], axis=2)

    kband, vband = band(kb), band(vb)
    blk = jnp.arange(n)[:, None, None] * BLOCK
    qpos = blk + jnp.arange(BLOCK)[None, :, None]
    kpos = blk - BLOCK + jnp.arange(3 * BLOCK)[None, None, :]
    mask = (jnp.abs(qpos - kpos) <= WINDOW) & (kpos >= 0) & (kpos < T)

    s_band = jnp.einsum('bnqkgd,bnskd->bnkgqs', qb, kband).astype(jnp.float32) * SCALE
    s_band = jnp.where(mask[None, :, None, None], s_band, NEG_INF)
    s_ctx = jnp.einsum('bnqkgd,bpkd->bnkgqp', qb, k_ctx).astype(jnp.float32) * SCALE
    sink_l = sink.reshape(N_KV_HEADS, Q_GROUP).astype(jnp.float32)
    sk = jnp.broadcast_to(sink_l[None, None, :, :, None, None], s_ctx.shape[:-1] + (1,))
    p = jax.nn.softmax(jnp.concatenate([s_ctx, s_band, sk], axis=-1), axis=-1)
    p_ctx = p[..., :P].astype(v.dtype)
    p_band = p[..., P:P + 3 * BLOCK].astype(v.dtype)
    o = (jnp.einsum('bnkgqp,bpkd->bnqkgd', p_ctx, v_ctx)
         + jnp.einsum('bnkgqs,bnskd->bnqkgd', p_band, vband))
    return o.reshape(B, T, D_Q)


def gmlp_branch(u, vg, w_s, b_s, g_norm):
    B, T = u.shape[0], u.shape[1]
    n = T // CHUNK
    u = jax.nn.gelu(u)
    vg = jax.nn.gelu(vg).reshape(B, n, CHUNK, GMLP_GROUPS, GMLP_GROUP_DIM)
    vg = rmsnorm(vg, g_norm)
    mixed = jnp.einsum('gpq,bnqgd->bnpgd', w_s, vg) + b_s.T[None, None, :, :, None]
    return u * mixed.reshape(B, T, D_GMLP)


def conv_ffn(xn, w_up, conv_w, conv_b, w_down):
    h = xn @ w_up
    T = h.shape[1]
    hp = jnp.pad(h, ((0, 0), (1, 1), (0, 0)))
    h = hp[:, :T] * conv_w[0] + hp[:, 1:T + 1] * conv_w[1] + hp[:, 2:T + 2] * conv_w[2] + conv_b
    a, b = jnp.split(h, 2, axis=-1)
    return (jax.nn.silu(a) * b) @ w_down


def trunk_layer(x, cvec, lp, attend):
    sh1, sc1, g1, sh2, sc2, g2 = adaln(cvec, lp['w_ada'], lp['b_ada'])
    B, T = x.shape[0], x.shape[1]
    xn = modulate(rmsnorm(x, lp['norm_mix']), sh1, sc1)
    h = xn @ lp['w_in']
    cuts = [D_Q, D_Q + D_KV, D_Q + 2 * D_KV, D_Q + 2 * D_KV + D_GMLP, D_Q + 2 * D_KV + 2 * D_GMLP]
    q, k, v, u, vg, gates = jnp.split(h, cuts, axis=-1)
    q = q.reshape(B, T, N_HEADS, HEAD_DIM)
    k = k.reshape(B, T, N_KV_HEADS, HEAD_DIM)
    v = v.reshape(B, T, N_KV_HEADS, HEAD_DIM)
    attn = attend(q, k, v)
    gm = gmlp_branch(u, vg, lp['w_s'], lp['b_s'], lp['gmlp_norm'])
    ga, gg = jnp.split(gates, 2, axis=-1)
    merged = jax.nn.sigmoid(ga) * (attn @ lp['w_o_attn']) + jax.nn.sigmoid(gg) * (gm @ lp['w_o_gmlp'])
    x = x + g1 * (merged @ lp['w_out'])
    xn = modulate(rmsnorm(x, lp['norm_ffn']), sh2, sc2)
    x = x + g2 * conv_ffn(xn, lp['w_up'], lp['conv_w'], lp['conv_b'], lp['w_down'])
    return x, k, v


def setup_inputs(seed: int = 0) -> dict:
    key = jax.random.key(seed)
    ks = jax.random.split(key, 24)
    f32 = jnp.float32
    nrm = lambda k, shape, s: jax.random.normal(k, shape, f32) * s
    return {
        'x_prompt': nrm(ks[0], (BATCH, SEQ, D_MODEL), 1.0),
        'x_sample': nrm(ks[1], (DEC_BATCH, DEC_SEQ, D_MODEL), 1.0),
        'cache_k': nrm(ks[2], (DEC_BATCH, DEPTH, PAST_LEN, N_KV_HEADS, HEAD_DIM), 1.0),
        'cache_v': nrm(ks[3], (DEC_BATCH, DEPTH, PAST_LEN, N_KV_HEADS, HEAD_DIM), 1.0),
        'c': nrm(ks[4], (DEC_BATCH, D_MODEL), 1.0),
        'c_ctx': nrm(ks[5], (D_MODEL,), 1.0),
        'w_ada': nrm(ks[6], (DEPTH, D_MODEL, 6 * D_MODEL), 0.5 * D_MODEL ** -0.5),
        'b_ada': nrm(ks[7], (DEPTH, 6 * D_MODEL), 0.02),
        'norm_mix': 1.0 + nrm(ks[8], (DEPTH, D_MODEL), 0.02),
        'norm_ffn': 1.0 + nrm(ks[9], (DEPTH, D_MODEL), 0.02),
        'w_in': nrm(ks[10], (DEPTH, D_MODEL, D_IN), D_MODEL ** -0.5),
        'sink': nrm(ks[11], (DEPTH, N_HEADS), 0.5),
        'w_s': nrm(ks[12], (DEPTH, GMLP_GROUPS, CHUNK, CHUNK), CHUNK ** -0.5),
        'b_s': 1.0 + nrm(ks[13], (DEPTH, GMLP_GROUPS, CHUNK), 0.02),
        'gmlp_norm': 1.0 + nrm(ks[14], (DEPTH, GMLP_GROUPS, GMLP_GROUP_DIM), 0.02),
        'w_o_attn': nrm(ks[15], (DEPTH, D_Q, D_MODEL), D_Q ** -0.5),
        'w_o_gmlp': nrm(ks[16], (DEPTH, D_GMLP, D_MODEL), D_GMLP ** -0.5),
        'w_out': nrm(ks[17], (DEPTH, D_MODEL, D_MODEL), D_MODEL ** -0.5),
        'w_up': nrm(ks[18], (DEPTH, D_MODEL, 2 * D_FF), D_MODEL ** -0.5),
        'conv_w': nrm(ks[19], (DEPTH, CONV_WIDTH, 2 * D_FF), 0.5),
        'conv_b': nrm(ks[20], (DEPTH, 2 * D_FF), 0.02),
        'w_down': nrm(ks[21], (DEPTH, D_FF, D_MODEL), D_FF ** -0.5),
        'norm_final': 1.0 + nrm(ks[22], (D_MODEL,), 0.02),
    }


def reference(x_prompt, x_sample, cache_k, cache_v, c, c_ctx, w_ada, b_ada, norm_mix, norm_ffn,
              w_in, sink, w_s, b_s, gmlp_norm, w_o_attn, w_o_gmlp, w_out, w_up, conv_w, conv_b,
              w_down, norm_final):
    T = x_sample.shape[1]
    ang_r, ang_c = axial_angles(T)
    c_lat = c[:, None, :]
    xp, xs = x_prompt, x_sample
    ks_out, vs_out = [], []
    for l in range(DEPTH):
        lp = {'w_ada': w_ada[l], 'b_ada': b_ada[l], 'norm_mix': norm_mix[l], 'norm_ffn': norm_ffn[l],
              'w_in': w_in[l], 'w_s': w_s[l], 'b_s': b_s[l], 'gmlp_norm': gmlp_norm[l],
              'w_o_attn': w_o_attn[l], 'w_o_gmlp': w_o_gmlp[l], 'w_out': w_out[l],
              'w_up': w_up[l], 'conv_w': conv_w[l], 'conv_b': conv_b[l], 'w_down': w_down[l]}
        sink_l = sink[l]
        xp, k_ctx, v_ctx = trunk_layer(
            xp, c_ctx, lp, lambda q, k, v: context_attention(q, k, v, sink_l))
        ks_out.append(k_ctx)
        vs_out.append(v_ctx)
        ck, cv = cache_k[:, l], cache_v[:, l]
        xs, _, _ = trunk_layer(
            xs, c_lat, lp,
            lambda q, k, v: latent_attention(apply_rope_2d(q, ang_r, ang_c), apply_rope_2d(k, ang_r, ang_c),
                                             v, ck, cv, sink_l))
    y_prompt = rmsnorm(xp, norm_final)
    y_sample = rmsnorm(xs, norm_final)
    state_k = jnp.stack(ks_out, axis=1)
    state_v = jnp.stack(vs_out, axis=1)
    return (y_prompt, y_sample, state_k, state_v)
```

```cpp
#include <hip/hip_runtime.h>
#include <math.h>
#include <stdint.h>

namespace nv {
constexpr int D = 1024, DIN = 5632, DFF = 2816, DQ = 1024, DKV = 256, HD = 128, NH = 8, NKV = 2;
constexpr int CH = 4096;
constexpr float EPS = 1e-6f;
constexpr int C_Q = 0, C_K = 1024, C_V = 1280, C_U = 1536, C_VG = 2560, C_GA = 3584, C_GG = 4608;

__device__ __forceinline__ float silu_f(float x) { return x / (1.f + expf(-x)); }
__device__ __forceinline__ float sigm_f(float x) { return 1.f / (1.f + expf(-x)); }
__device__ __forceinline__ float gelu_f(float x) { const float c = 0.7978845608028654f; return 0.5f * x * (1.f + tanhf(c * (x + 0.044715f * x * x * x))); }
__device__ __forceinline__ float wsum(float v) {
#pragma unroll
    for (int o = 1; o < 64; o <<= 1) v += __shfl_xor(v, o);
    return v;
}
__device__ __forceinline__ float wmax(float v) {
#pragma unroll
    for (int o = 1; o < 64; o <<= 1) v = fmaxf(v, __shfl_xor(v, o));
    return v;
}

__global__ void adaln_kernel(const float* c_ctx, const float* c, const float* w_ada, const float* b_ada, float* m) {
    const int j = blockIdx.x * 256 + threadIdx.x, cond = blockIdx.y;
    const float* cv = cond == 0 ? c_ctx : c + (cond - 1) * D;
    float acc = 0.f;
    for (int k = 0; k < D; ++k) acc += silu_f(cv[k]) * w_ada[(size_t)k * 6 * D + j];
    m[cond * 6 * D + j] = acc + b_ada[j];
}

__global__ void norm_mod_kernel(const float* x, const float* g, const float* sh, const float* sc, float* out, int rows) {
    const int row = blockIdx.x * 4 + (threadIdx.x >> 6), lane = threadIdx.x & 63;
    if (row >= rows) return;
    const float* xr = x + (size_t)row * D;
    float v[16]; float s = 0.f;
#pragma unroll
    for (int i = 0; i < 16; ++i) { v[i] = xr[lane + 64 * i]; s += v[i] * v[i]; }
    s = wsum(s);
    const float r = rsqrtf(s / D + EPS);
#pragma unroll
    for (int i = 0; i < 16; ++i) { const int cidx = lane + 64 * i; out[(size_t)row * D + cidx] = v[i] * r * g[cidx] * (1.f + sc[cidx]) + sh[cidx]; }
}

__global__ void __launch_bounds__(256) gemm_f32(const float* A, int lda, const float* B, int ldb, float* C, int ldc, int K) {
    __shared__ float As[16][68];
    __shared__ float Bs[16][68];
    const int t = threadIdx.x, tx = t & 15, ty = t >> 4;
    const int m0 = blockIdx.y * 64, n0 = blockIdx.x * 64;
    float acc[4][4];
#pragma unroll
    for (int i = 0; i < 4; ++i)
#pragma unroll
        for (int j = 0; j < 4; ++j) acc[i][j] = 0.f;
    for (int k0 = 0; k0 < K; k0 += 16) {
        {
            const int row = t >> 2, kk = (t & 3) * 4;
            const float4 a = *(const float4*)(A + (size_t)(m0 + row) * lda + k0 + kk);
            As[kk + 0][row] = a.x; As[kk + 1][row] = a.y; As[kk + 2][row] = a.z; As[kk + 3][row] = a.w;
            const int kb = t >> 4, nn = (t & 15) * 4;
            const float4 b = *(const float4*)(B + (size_t)(k0 + kb) * ldb + n0 + nn);
            Bs[kb][nn + 0] = b.x; Bs[kb][nn + 1] = b.y; Bs[kb][nn + 2] = b.z; Bs[kb][nn + 3] = b.w;
        }
        __syncthreads();
#pragma unroll
        for (int kk = 0; kk < 16; ++kk) {
            float a[4], b[4];
#pragma unroll
            for (int i = 0; i < 4; ++i) a[i] = As[kk][ty * 4 + i];
#pragma unroll
            for (int j = 0; j < 4; ++j) b[j] = Bs[kk][tx * 4 + j];
#pragma unroll
            for (int i = 0; i < 4; ++i)
#pragma unroll
                for (int j = 0; j < 4; ++j) acc[i][j] += a[i] * b[j];
        }
        __syncthreads();
    }
#pragma unroll
    for (int i = 0; i < 4; ++i) {
        float4 o; o.x = acc[i][0]; o.y = acc[i][1]; o.z = acc[i][2]; o.w = acc[i][3];
        *(float4*)(C + (size_t)(m0 + ty * 4 + i) * ldc + n0 + tx * 4) = o;
    }
}

__global__ void rope_kernel(float* h) {
    const int t = blockIdx.x;
    const int tid = threadIdx.x;
    const int head = tid >> 6, l = tid & 63, half = l >> 5, f = l & 31;
    const int colbase = (head < 8 ? C_Q + head * HD : C_K + (head - 8) * HD) + half * 64;
    const float pos = half == 0 ? (float)(t / 64) : (float)(t % 64);
    const float inv = powf(10000.f, -(float)f / 32.f);
    const float ang = pos * inv;
    const double ad = (double)ang;
    const float cs = (float)cos(ad), sn = (float)sin(ad);
    float* p = h + (size_t)t * DIN + colbase;
    const float x1 = p[f], x2 = p[f + 32];
    p[f] = x1 * cs - x2 * sn; p[f + 32] = x1 * sn + x2 * cs;
}

__global__ void __launch_bounds__(256) attn_naive(const float* h, const float* cache_k, const float* cache_v, const float* sink, float* out, int mode) {
    __shared__ float qs[4][HD];
    __shared__ float sc[4][520];
    __shared__ float red[4][2];
    const int r = blockIdx.x, kvh = blockIdx.y, tid = threadIdx.x;
    const float scale = 0.08838834764831845f;
    for (int i = tid; i < 4 * HD; i += 256) qs[i >> 7][i & 127] = h[(size_t)r * DIN + C_Q + (kvh * 4 + (i >> 7)) * HD + (i & 127)];
    __syncthreads();
    int nctx = 256, lo = 0, nband = 0;
    if (mode == 1) { lo = r - 128 < 0 ? 0 : r - 128; int hi = r + 128 > CH - 1 ? CH - 1 : r + 128; nband = hi - lo + 1; }
    const int nk = nctx + nband;
    const int seq0 = (r / 256) * 256;
    for (int idx = tid; idx < 4 * nk; idx += 256) {
        const int g = idx / nk, j = idx % nk;
        const float* kp;
        if (mode == 0) kp = h + (size_t)(seq0 + j) * DIN + C_K + kvh * HD;
        else kp = j < 256 ? cache_k + (size_t)j * 256 + kvh * HD : h + (size_t)(lo + j - 256) * DIN + C_K + kvh * HD;
        float a = 0.f;
        for (int d = 0; d < HD; ++d) a += qs[g][d] * kp[d];
        sc[g][j] = a * scale;
    }
    __syncthreads();
    {
        const int g = tid >> 6, lane = tid & 63;
        const float sk = sink[kvh * 4 + g];
        float mx = sk;
        for (int j = lane; j < nk; j += 64) mx = fmaxf(mx, sc[g][j]);
        mx = wmax(mx);
        float s = 0.f;
        for (int j = lane; j < nk; j += 64) { const float e = expf(sc[g][j] - mx); sc[g][j] = e; s += e; }
        s = wsum(s) + expf(sk - mx);
        if (lane == 0) red[g][0] = 1.f / s;
    }
    __syncthreads();
    for (int o = tid; o < 4 * HD; o += 256) {
        const int g = o >> 7, d = o & 127;
        float a = 0.f;
        for (int j = 0; j < nk; ++j) {
            const float* vp;
            if (mode == 0) vp = h + (size_t)(seq0 + j) * DIN + C_V + kvh * HD;
            else vp = j < 256 ? cache_v + (size_t)j * 256 + kvh * HD : h + (size_t)(lo + j - 256) * DIN + C_V + kvh * HD;
            a += sc[g][j] * vp[d];
        }
        out[(size_t)r * DQ + (kvh * 4 + g) * HD + d] = a * red[g][0];
    }
}

__global__ void __launch_bounds__(256) gmlp_naive(const float* h, const float* w_s, const float* b_s, const float* gnorm, float* gm) {
    __shared__ float tile[128][64];
    __shared__ float rstd[128];
    const int cn = blockIdx.x, g = blockIdx.y, dh = blockIdx.z, tid = threadIdx.x;
    const int r0 = cn * 128;
    {
        const int q = tid >> 1, hf = tid & 1;
        const float* p = h + (size_t)(r0 + q) * DIN + C_VG + g * 128 + hf * 64;
        float s = 0.f;
        for (int d = 0; d < 64; ++d) { const float v = gelu_f(p[d]); s += v * v; }
        s += __shfl_xor(s, 1);
        if (hf == 0) rstd[q] = rsqrtf(s / 128.f + EPS);
    }
    __syncthreads();
    for (int i = tid; i < 128 * 64; i += 256) {
        const int q = i >> 6, d = i & 63;
        tile[q][d] = gelu_f(h[(size_t)(r0 + q) * DIN + C_VG + g * 128 + dh * 64 + d]) * rstd[q] * gnorm[g * 128 + dh * 64 + d];
    }
    __syncthreads();
    const int dcol = tid & 63, pg = tid >> 6;
    float acc[32];
#pragma unroll
    for (int i = 0; i < 32; ++i) acc[i] = 0.f;
    for (int q = 0; q < 128; ++q) {
        const float v = tile[q][dcol];
#pragma unroll
        for (int i = 0; i < 32; ++i) acc[i] += w_s[((size_t)g * 128 + pg * 32 + i) * 128 + q] * v;
    }
#pragma unroll
    for (int i = 0; i < 32; ++i) {
        const int p = pg * 32 + i;
        const float u = gelu_f(h[(size_t)(r0 + p) * DIN + C_U + g * 128 + dh * 64 + dcol]);
        gm[(size_t)(r0 + p) * D + g * 128 + dh * 64 + dcol] = u * (acc[i] + b_s[g * 128 + p]);
    }
}

__global__ void merge_kernel(const float* h, float* P, const float* Qg) {
    const size_t i = (size_t)blockIdx.x * 256 + threadIdx.x;
    const int r = (int)(i >> 10), cidx = (int)(i & 1023);
    const float ga = h[(size_t)r * DIN + C_GA + cidx], gg = h[(size_t)r * DIN + C_GG + cidx];
    P[i] = sigm_f(ga) * P[i] + sigm_f(gg) * Qg[i];
}

__global__ void resid_kernel(const float* x, const float* g, const float* t, float* o) {
    const size_t i = (size_t)blockIdx.x * 256 + threadIdx.x;
    o[i] = x[i] + g[i & 1023] * t[i];
}

__global__ void conv_act_kernel(const float* h2, const float* cw, const float* cb, float* act, int seqlen) {
    const size_t i = (size_t)blockIdx.x * 256 + threadIdx.x;
    const int r = (int)(i / DFF), j = (int)(i % DFF);
    const int tpos = r % seqlen;
    float ab[2];
#pragma unroll
    for (int s = 0; s < 2; ++s) {
        const int cidx = j + s * DFF;
        const float hm = tpos > 0 ? h2[(size_t)(r - 1) * DIN + cidx] : 0.f;
        const float h0 = h2[(size_t)r * DIN + cidx];
        const float hp = tpos < seqlen - 1 ? h2[(size_t)(r + 1) * DIN + cidx] : 0.f;
        ab[s] = hm * cw[cidx] + h0 * cw[DIN + cidx] + hp * cw[2 * DIN + cidx] + cb[cidx];
    }
    act[i] = silu_f(ab[0]) * ab[1];
}

__global__ void final_kernel(const float* x1, const float* g2, const float* t2, const float* nf, float* y, int rows) {
    const int row = blockIdx.x * 4 + (threadIdx.x >> 6), lane = threadIdx.x & 63;
    if (row >= rows) return;
    float v[16]; float s = 0.f;
#pragma unroll
    for (int i = 0; i < 16; ++i) { const int cidx = lane + 64 * i; v[i] = x1[(size_t)row * D + cidx] + g2[cidx] * t2[(size_t)row * D + cidx]; s += v[i] * v[i]; }
    s = wsum(s);
    const float r = rsqrtf(s / D + EPS);
#pragma unroll
    for (int i = 0; i < 16; ++i) { const int cidx = lane + 64 * i; y[(size_t)row * D + cidx] = v[i] * r * nf[cidx]; }
}

__global__ void copy_kv_kernel(const float* h, float* sk, float* sv) {
    const size_t i = (size_t)blockIdx.x * 256 + threadIdx.x;
    const int r = (int)(i >> 8), cidx = (int)(i & 255);
    sk[i] = h[(size_t)r * DIN + C_K + cidx];
    sv[i] = h[(size_t)r * DIN + C_V + cidx];
}
}

extern "C" void kernel_launch(void* const* d_in, const int* in_sizes, int n_in, void* d_out, int out_size, void* d_ws, size_t ws_size, hipStream_t stream) {
    using namespace nv;
    const float* x_prompt = (const float*)d_in[0]; const float* x_sample = (const float*)d_in[1];
    const float* cache_k = (const float*)d_in[2]; const float* cache_v = (const float*)d_in[3];
    const float* c = (const float*)d_in[4]; const float* c_ctx = (const float*)d_in[5];
    const float* w_ada = (const float*)d_in[6]; const float* b_ada = (const float*)d_in[7];
    const float* norm_mix = (const float*)d_in[8]; const float* norm_ffn = (const float*)d_in[9];
    const float* w_in = (const float*)d_in[10]; const float* sink = (const float*)d_in[11];
    const float* w_s = (const float*)d_in[12]; const float* b_s = (const float*)d_in[13]; const float* gnorm = (const float*)d_in[14];
    const float* w_o_attn = (const float*)d_in[15]; const float* w_o_gmlp = (const float*)d_in[16]; const float* w_out = (const float*)d_in[17];
    const float* w_up = (const float*)d_in[18]; const float* conv_w = (const float*)d_in[19]; const float* conv_b = (const float*)d_in[20];
    const float* w_down = (const float*)d_in[21]; const float* norm_final = (const float*)d_in[22];
    float* out = (float*)d_out;
    float* y_prompt = out; float* y_sample = out + (size_t)8192 * 1024; float* state_k = y_sample + (size_t)8192 * 1024; float* state_v = state_k + (size_t)8192 * 256;

    const size_t MiB = 1u << 20;
    char* ws = (char*)d_ws;
    float* mvec = (float*)(ws);
    float* A0 = (float*)(ws + 1 * MiB);
    float* H = (float*)(ws + 17 * MiB);
    float* B1 = (float*)(ws + 105 * MiB);
    float* B2 = (float*)(ws + 121 * MiB);
    float* B3 = (float*)(ws + 137 * MiB);
    float* B4 = (float*)(ws + 153 * MiB);
    float* X1 = (float*)(ws + 169 * MiB);
    float* ACT = (float*)(ws + 185 * MiB);

    adaln_kernel<<<dim3(6 * D / 256, 3), 256, 0, stream>>>(c_ctx, c, w_ada, b_ada, mvec);
    for (int chunk = 0; chunk < 4; ++chunk) {
        const bool lat = chunk >= 2;
        const int cond = lat ? chunk - 1 : 0;
        const float* x = lat ? x_sample + (size_t)(chunk - 2) * CH * D : x_prompt + (size_t)chunk * CH * D;
        float* y = lat ? y_sample + (size_t)(chunk - 2) * CH * D : y_prompt + (size_t)chunk * CH * D;
        const float* m = mvec + cond * 6 * D;
        const float *sh1 = m, *sc1 = m + D, *g1 = m + 2 * D, *sh2 = m + 3 * D, *sc2 = m + 4 * D, *g2 = m + 5 * D;
        norm_mod_kernel<<<CH / 4, 256, 0, stream>>>(x, norm_mix, sh1, sc1, A0, CH);
        gemm_f32<<<dim3(DIN / 64, CH / 64), 256, 0, stream>>>(A0, D, w_in, DIN, H, DIN, D);
        if (!lat) copy_kv_kernel<<<CH, 256, 0, stream>>>(H, state_k + (size_t)chunk * CH * 256, state_v + (size_t)chunk * CH * 256);
        if (lat) rope_kernel<<<CH, 640, 0, stream>>>(H);
        attn_naive<<<dim3(CH, 2), 256, 0, stream>>>(H, lat ? cache_k + (size_t)(chunk - 2) * 256 * 256 : nullptr, lat ? cache_v + (size_t)(chunk - 2) * 256 * 256 : nullptr, sink, B1, lat ? 1 : 0);
        gmlp_naive<<<dim3(CH / 128, 8, 2), 256, 0, stream>>>(H, w_s, b_s, gnorm, B2);
        gemm_f32<<<dim3(D / 64, CH / 64), 256, 0, stream>>>(B1, D, w_o_attn, D, B3, D, D);
        gemm_f32<<<dim3(D / 64, CH / 64), 256, 0, stream>>>(B2, D, w_o_gmlp, D, B4, D, D);
        merge_kernel<<<CH * D / 256, 256, 0, stream>>>(H, B3, B4);
        gemm_f32<<<dim3(D / 64, CH / 64), 256, 0, stream>>>(B3, D, w_out, D, B1, D, D);
        resid_kernel<<<CH * D / 256, 256, 0, stream>>>(x, g1, B1, X1);
        norm_mod_kernel<<<CH / 4, 256, 0, stream>>>(X1, norm_ffn, sh2, sc2, A0, CH);
        gemm_f32<<<dim3(DIN / 64, CH / 64), 256, 0, stream>>>(A0, D, w_up, DIN, H, DIN, D);
        conv_act_kernel<<<(unsigned)((size_t)CH * DFF / 256), 256, 0, stream>>>(H, conv_w, conv_b, ACT, lat ? 4096 : 256);
        gemm_f32<<<dim3(D / 64, CH / 64), 256, 0, stream>>>(ACT, DFF, w_down, D, B2, D, DFF);
        final_kernel<<<CH / 4, 256, 0, stream>>>(X1, g2, B2, norm_final, y, CH);
    }
}
```

```cpp
#define FASTMASK 0x3ff
#define ONE_LAUNCH 1
#include <hip/hip_runtime.h>
#include <math.h>
#include <stdint.h>
#include <cstdio>

namespace L {
constexpr int M = 16384, MC = 8192, D = 1024, DIN = 5632, DFF = 2816, TLAT = 4096;
constexpr float EPS = 1e-6f;
constexpr float LOG2E = 1.4426950408889634f;
constexpr float QSCALE = 0.08838834764831845f * LOG2E;
constexpr size_t MiB = 1u << 20;
constexpr size_t CTL_ZERO = 512 * 1024;
constexpr size_t OFF_BAR = 16384;
constexpr size_t OFF_MVEC = 32768;
constexpr size_t OFF_BIAS1 = OFF_MVEC + 3 * 6144 * 4;
constexpr size_t OFF_BIASUP = OFF_BIAS1 + 3 * 5632 * 4;
constexpr size_t OFF_SSQ2 = OFF_BIASUP + 3 * 5632 * 4;
constexpr size_t OFF_SSQ3 = OFF_SSQ2 + M * 4;
static_assert(OFF_SSQ3 + M * 4 <= CTL_ZERO, "ctl");
constexpr size_t OFF_RSTD1 = CTL_ZERO;
constexpr size_t OFF_PRM = OFF_RSTD1 + M * 4;
constexpr size_t OFF_ROPE = OFF_PRM + 3 * 6 * 1024 * 4;
static_assert(OFF_ROPE + 64 * 32 * 2 * 4 <= 2 * MiB, "small");
constexpr size_t WS_WIN = 2 * MiB;
constexpr size_t WS_WUP = 13 * MiB;
constexpr size_t WS_WCAT = 24 * MiB;
constexpr size_t WS_WOUT = 28 * MiB;
constexpr size_t WS_WDOWN = 30 * MiB;
constexpr size_t WS_WS = 35 * MiB + 512 * 1024;
constexpr size_t WS_XB = 36 * MiB;
constexpr size_t WS_AG = 36 * MiB;
constexpr size_t WS_ACT = 36 * MiB;
constexpr size_t WS_Q = 100 * MiB;
constexpr size_t WS_MRG = 100 * MiB;
constexpr size_t WS_K = 132 * MiB;
constexpr size_t WS_V = 140 * MiB;
constexpr size_t WS_U = 148 * MiB;
constexpr size_t WS_VG = 180 * MiB;
constexpr size_t WS_X1 = 148 * MiB;
constexpr size_t WS_X1B = 212 * MiB;
constexpr size_t WS_SIDE = 244 * MiB;
constexpr size_t WS_CK = 248 * MiB;
constexpr size_t WS_CV = 249 * MiB;
constexpr size_t WS_END = 256 * MiB;
constexpr int C_K = 1024, C_V = 1280, C_U = 1536, C_VG = 2560, C_GA = 3584, C_GG = 4608;

typedef unsigned short bf16;
__host__ __device__ __forceinline__ int sig_in(int rho) {
    if (rho >= C_V) return rho;
    const int p = rho & 127, hb = rho - p, gi = p >> 3, n = (p >> 2) & 1, e = p & 3;
    const int base = gi < 8 ? 4 * gi : 64 + 4 * (gi - 8);
    return hb + base + 32 * n + e;
}
__host__ __device__ __forceinline__ int sig_up(int rho) {
    const int t = rho >> 8, c = rho & 255;
    return c < 128 ? t * 128 + c : DFF + t * 128 + (c - 128);
}
__device__ __forceinline__ int cond_of(int m) { return m < MC ? 0 : 1 + ((m - MC) >> 12); }
__device__ __forceinline__ unsigned f2bf(float f) { unsigned u = __builtin_bit_cast(unsigned, f); return (u + 0x7fffu + ((u >> 16) & 1u)) >> 16; }
__device__ __forceinline__ float bf2f(unsigned short b) { return __builtin_bit_cast(float, (unsigned)b << 16); }
__device__ __forceinline__ float silu_f(float x) { return x / (1.f + __builtin_amdgcn_exp2f(-x * LOG2E)); }
__device__ __forceinline__ float sigm_f(float x) { return 1.f / (1.f + __builtin_amdgcn_exp2f(-x * LOG2E)); }
__device__ __forceinline__ float gelu_f(float x) { const float z = 0.7978845608028654f * (x + 0.044715f * x * x * x); return x / (1.f + __builtin_amdgcn_exp2f(-2.f * LOG2E * z)); }
__device__ __forceinline__ float wsum(float v) {
#pragma unroll
    for (int o = 1; o < 64; o <<= 1) v += __shfl_xor(v, o);
    return v;
}
__device__ __forceinline__ float wmax(float v) {
#pragma unroll
    for (int o = 1; o < 64; o <<= 1) v = fmaxf(v, __shfl_xor(v, o));
    return v;
}
struct Ptrs {
    const float *x_prompt, *x_sample, *cache_k, *cache_v, *c, *c_ctx, *w_ada, *b_ada, *norm_mix, *norm_ffn, *w_in, *sink, *w_s, *b_s, *gnorm,
        *w_o_attn, *w_o_gmlp, *w_out, *w_up, *conv_w, *conv_b, *w_down, *norm_final;
    float* out; unsigned char* ws;
};
__device__ __forceinline__ const float* xrow(const Ptrs& P, int m) { return m < MC ? P.x_prompt + (size_t)m * D : P.x_sample + (size_t)(m - MC) * D; }
}

namespace nv {
using namespace L;

__global__ void n_adaln(Ptrs P) {
    const int j = blockIdx.x * 256 + threadIdx.x, cond = blockIdx.y;
    const float* cv = cond == 0 ? P.c_ctx : P.c + (cond - 1) * D;
    float acc = 0.f;
    for (int k = 0; k < D; ++k) acc += silu_f(cv[k]) * P.w_ada[(size_t)k * 6 * D + j];
    ((float*)(P.ws + OFF_MVEC))[cond * 6 * D + j] = acc;
}
template <int MODE> __global__ void n_wconv(const float* src, int K, int N, bf16* dst, int ldd, int koff, int nrows) {
    const size_t i = (size_t)blockIdx.x * 256 + threadIdx.x;
    if (i >= (size_t)nrows * K) return;
    const int rho = (int)(i % nrows), k = (int)(i / nrows);
    const int s = MODE == 1 ? sig_in(rho) : MODE == 2 ? sig_up(rho) : rho;
    dst[(size_t)rho * ldd + koff + k] = (bf16)f2bf(src[(size_t)k * N + s]);
}
__global__ void n_misc(Ptrs P) {
    const int i = blockIdx.x * 256 + threadIdx.x;
    if (i < 64 * 32) {
        const int pos = i >> 5, f = i & 31;
        const float inv = exp2f(-(float)f / 32.f * 13.287712379549449f);
        const float ang = (float)pos * inv;
        const double a = (double)ang;
        float* t = (float*)(P.ws + OFF_ROPE);
        t[2 * i] = (float)cos(a); t[2 * i + 1] = (float)sin(a);
    }
    if (i < 8 * 128 * 128) ((bf16*)(P.ws + WS_WS))[i] = (bf16)f2bf(P.w_s[i]);
    if (i < 2 * 256 * 256) { ((bf16*)(P.ws + WS_CK))[i] = (bf16)f2bf(P.cache_k[i]); ((bf16*)(P.ws + WS_CV))[i] = (bf16)f2bf(P.cache_v[i]); }
}
__global__ void n_prm(Ptrs P) {
    const int i = blockIdx.x * 256 + threadIdx.x;
    const int cond = i >> 10, k = i & 1023;
    const float* mv = (const float*)(P.ws + OFF_MVEC) + cond * 6 * D;
    float* prm = (float*)(P.ws + OFF_PRM) + cond * 6 * D;
    float m6[6];
#pragma unroll
    for (int s = 0; s < 6; ++s) m6[s] = mv[s * D + k] + P.b_ada[s * D + k];
    prm[0 * D + k] = m6[0];
    prm[1 * D + k] = P.norm_mix[k] * (1.f + m6[1]);
    prm[2 * D + k] = m6[2];
    prm[3 * D + k] = m6[3];
    prm[4 * D + k] = P.norm_ffn[k] * (1.f + m6[4]);
    prm[5 * D + k] = m6[5];
}
__global__ void n_xb(Ptrs P) {
    const int m = blockIdx.x * 4 + (threadIdx.x >> 6), lane = threadIdx.x & 63;
    const float* xr = xrow(P, m);
    const float* s1 = (const float*)(P.ws + OFF_PRM) + cond_of(m) * 6 * D + D;
    bf16* xb = (bf16*)(P.ws + WS_XB) + (size_t)m * D;
    float s = 0.f;
    for (int i = 0; i < 16; ++i) { const int k = lane + 64 * i; const float v = xr[k]; s += v * v; xb[k] = (bf16)f2bf(v * s1[k]); }
    s = wsum(s);
    if (lane == 0) ((float*)(P.ws + OFF_RSTD1))[m] = rsqrtf(s / D + EPS);
}
__global__ void n_bias(Ptrs P) {
    const int n = blockIdx.x * 256 + threadIdx.x, cond = blockIdx.y, which = blockIdx.z;
    const float* prm = (const float*)(P.ws + OFF_PRM) + cond * 6 * D + (which ? 3 * D : 0);
    const float* W = which ? P.w_up : P.w_in;
    float acc = 0.f;
    for (int k = 0; k < D; ++k) acc += prm[k] * W[(size_t)k * DIN + n];
    ((float*)(P.ws + (which ? OFF_BIASUP : OFF_BIAS1)))[cond * DIN + n] = acc;
}
template <class Epi> __global__ void __launch_bounds__(256) n_gemm(const bf16* A, int lda, const bf16* Bt, int ldb, int K, Epi E) {
    __shared__ float As[16][68];
    __shared__ float Bs[16][68];
    const int t = threadIdx.x, tx = t & 15, ty = t >> 4;
    const int m0 = blockIdx.y * 64, n0 = blockIdx.x * 64;
    float acc[4][4];
#pragma unroll
    for (int i = 0; i < 4; ++i)
#pragma unroll
        for (int j = 0; j < 4; ++j) acc[i][j] = 0.f;
    for (int k0 = 0; k0 < K; k0 += 16) {
        {
            const int row = t >> 2, kk = (t & 3) * 4;
            const ushort4 a = *(const ushort4*)(A + (size_t)(m0 + row) * lda + k0 + kk);
            As[kk + 0][row] = bf2f(a.x); As[kk + 1][row] = bf2f(a.y); As[kk + 2][row] = bf2f(a.z); As[kk + 3][row] = bf2f(a.w);
            const ushort4 b = *(const ushort4*)(Bt + (size_t)(n0 + row) * ldb + k0 + kk);
            Bs[kk + 0][row] = bf2f(b.x); Bs[kk + 1][row] = bf2f(b.y); Bs[kk + 2][row] = bf2f(b.z); Bs[kk + 3][row] = bf2f(b.w);
        }
        __syncthreads();
#pragma unroll
        for (int kk = 0; kk < 16; ++kk) {
            float a[4], b[4];
#pragma unroll
            for (int i = 0; i < 4; ++i) a[i] = As[kk][ty * 4 + i];
#pragma unroll
            for (int j = 0; j < 4; ++j) b[j] = Bs[kk][tx * 4 + j];
#pragma unroll
            for (int i = 0; i < 4; ++i)
#pragma unroll
                for (int j = 0; j < 4; ++j) acc[i][j] += a[i] * b[j];
        }
        __syncthreads();
    }
#pragma unroll
    for (int i = 0; i < 4; ++i)
#pragma unroll
        for (int j = 0; j < 4; ++j) E(m0 + ty * 4 + i, n0 + tx * 4 + j, acc[i][j]);
}
struct EpiG1 {
    Ptrs P;
    __device__ void operator()(int m, int rho, float acc) const {
        const int cond = cond_of(m), s = sig_in(rho);
        const float v = ((const float*)(P.ws + OFF_RSTD1))[m] * acc + ((const float*)(P.ws + OFF_BIAS1))[cond * DIN + s];
        float* state_k = P.out + (size_t)M * D; float* state_v = state_k + (size_t)MC * 256;
        if (rho < C_K) ((bf16*)(P.ws + WS_Q))[(size_t)m * D + s] = (bf16)f2bf(v);
        else if (rho < C_V) { ((bf16*)(P.ws + WS_K))[(size_t)m * 256 + s - C_K] = (bf16)f2bf(v); if (m < MC) state_k[(size_t)m * 256 + s - C_K] = v; }
        else if (rho < C_U) { ((bf16*)(P.ws + WS_V))[(size_t)m * 256 + s - C_V] = (bf16)f2bf(v); if (m < MC) state_v[(size_t)m * 256 + s - C_V] = v; }
        else if (rho < C_VG) ((bf16*)(P.ws + WS_U))[(size_t)m * D + s - C_U] = (bf16)f2bf(gelu_f(v));
        else if (rho < C_GA) ((bf16*)(P.ws + WS_VG))[(size_t)m * D + s - C_VG] = (bf16)f2bf(gelu_f(v));
        else if (rho < C_GG) ((bf16*)(P.out))[(size_t)m * D + s - C_GA] = (bf16)f2bf(sigm_f(v));
        else ((bf16*)((unsigned char*)P.out + 32 * MiB))[(size_t)m * D + s - C_GG] = (bf16)f2bf(sigm_f(v));
    }
};
__global__ void n_rope_scale(Ptrs P) {
    const int m = blockIdx.x, tid = threadIdx.x, head = tid >> 6, l = tid & 63, half = l >> 5, f = l & 31;
    bf16* p = head < 8 ? (bf16*)(P.ws + WS_Q) + (size_t)m * D + head * 128 + half * 64 : (bf16*)(P.ws + WS_K) + (size_t)m * 256 + (head - 8) * 128 + half * 64;
    float x1 = bf2f(p[f]), x2 = bf2f(p[f + 32]);
    if (m >= MC) {
        const int t = (m - MC) & (TLAT - 1);
        const int pos = half == 0 ? t >> 6 : t & 63;
        const float* tab = (const float*)(P.ws + OFF_ROPE) + (pos * 32 + f) * 2;
        const float cs = tab[0], sn = tab[1];
        const float o1 = x1 * cs - x2 * sn, o2 = x1 * sn + x2 * cs; x1 = o1; x2 = o2;
    }
    const float sc = head < 8 ? QSCALE : 1.f;
    p[f] = (bf16)f2bf(x1 * sc); p[f + 32] = (bf16)f2bf(x2 * sc);
}
__global__ void __launch_bounds__(256) n_attn(Ptrs P) {
    __shared__ float qs[4][128];
    __shared__ float sc[4][520];
    __shared__ float red[4];
    const int m = blockIdx.x, kvh = blockIdx.y, tid = threadIdx.x;
    const bf16* Q = (const bf16*)(P.ws + WS_Q); const bf16* K = (const bf16*)(P.ws + WS_K); const bf16* V = (const bf16*)(P.ws + WS_V);
    const bf16* CK = (const bf16*)(P.ws + WS_CK); const bf16* CV = (const bf16*)(P.ws + WS_CV);
    for (int i = tid; i < 512; i += 256) qs[i >> 7][i & 127] = bf2f(Q[(size_t)m * D + (kvh * 4 + (i >> 7)) * 128 + (i & 127)]);
    __syncthreads();
    const bool lat = m >= MC;
    int nk = 256, lo = 0, seq0 = (m >> 8) << 8, bl = 0;
    if (lat) { bl = (m - MC) >> 12; const int t = (m - MC) & 4095; lo = t - 128 < 0 ? 0 : t - 128; const int hi = t + 128 > 4095 ? 4095 : t + 128; nk = 256 + hi - lo + 1; seq0 = MC + bl * 4096; }
    for (int idx = tid; idx < 4 * nk; idx += 256) {
        const int g = idx / nk, j = idx % nk;
        const bf16* kp = !lat ? K + (size_t)(seq0 + j) * 256 + kvh * 128 : (j < 256 ? CK + ((size_t)bl * 256 + j) * 256 + kvh * 128 : K + (size_t)(seq0 + lo + j - 256) * 256 + kvh * 128);
        float a = 0.f;
        for (int d = 0; d < 128; ++d) a += qs[g][d] * bf2f(kp[d]);
        sc[g][j] = a;
    }
    __syncthreads();
    {
        const int g = tid >> 6, lane = tid & 63;
        const float sk = P.sink[kvh * 4 + g] * LOG2E;
        float mx = sk;
        for (int j = lane; j < nk; j += 64) mx = fmaxf(mx, sc[g][j]);
        mx = wmax(mx);
        float s = 0.f;
        for (int j = lane; j < nk; j += 64) { const float e = exp2f(sc[g][j] - mx); sc[g][j] = bf2f((bf16)f2bf(e)); s += e; }
        s = wsum(s) + exp2f(sk - mx);
        if (lane == 0) red[g] = 1.f / s;
    }
    __syncthreads();
    for (int o = tid; o < 512; o += 256) {
        const int g = o >> 7, d = o & 127;
        float a = 0.f;
        for (int j = 0; j < nk; ++j) {
            const bf16* vp = !lat ? V + (size_t)(seq0 + j) * 256 + kvh * 128 : (j < 256 ? CV + ((size_t)bl * 256 + j) * 256 + kvh * 128 : V + (size_t)(seq0 + lo + j - 256) * 256 + kvh * 128);
            a += sc[g][j] * bf2f(vp[d]);
        }
        ((bf16*)(P.ws + WS_AG))[(size_t)m * 2048 + (kvh * 4 + g) * 128 + d] = (bf16)f2bf(a * red[g]);
    }
}
__global__ void __launch_bounds__(256) n_mix(Ptrs P) {
    __shared__ float tile[128][64];
    __shared__ float rstd[128];
    const int cn = blockIdx.x, g = blockIdx.y, dh = blockIdx.z, tid = threadIdx.x;
    const int r0 = cn * 128;
    const bf16* VG = (const bf16*)(P.ws + WS_VG); const bf16* U = (const bf16*)(P.ws + WS_U); const bf16* WS = (const bf16*)(P.ws + WS_WS);
    {
        const int q = tid >> 1, hf = tid & 1;
        const bf16* p = VG + (size_t)(r0 + q) * D + g * 128 + hf * 64;
        float s = 0.f;
        for (int d = 0; d < 64; ++d) { const float v = bf2f(p[d]); s += v * v; }
        s += __shfl_xor(s, 1);
        if (hf == 0) rstd[q] = rsqrtf(s / 128.f + EPS);
    }
    __syncthreads();
    for (int i = tid; i < 128 * 64; i += 256) {
        const int q = i >> 6, d = i & 63;
        tile[q][d] = bf2f((bf16)f2bf(bf2f(VG[(size_t)(r0 + q) * D + g * 128 + dh * 64 + d]) * rstd[q] * P.gnorm[g * 128 + dh * 64 + d]));
    }
    __syncthreads();
    const int dcol = tid & 63, pg = tid >> 6;
    float acc[32];
#pragma unroll
    for (int i = 0; i < 32; ++i) acc[i] = 0.f;
    for (int q = 0; q < 128; ++q) {
        const float v = tile[q][dcol];
#pragma unroll
        for (int i = 0; i < 32; ++i) acc[i] += bf2f(WS[((size_t)g * 128 + pg * 32 + i) * 128 + q]) * v;
    }
#pragma unroll
    for (int i = 0; i < 32; ++i) {
        const int p = pg * 32 + i;
        const float u = bf2f(U[(size_t)(r0 + p) * D + g * 128 + dh * 64 + dcol]);
        ((bf16*)(P.ws + WS_AG))[(size_t)(r0 + p) * 2048 + 1024 + g * 128 + dh * 64 + dcol] = (bf16)f2bf(u * (acc[i] + P.b_s[g * 128 + p]));
    }
}
struct EpiG3a { Ptrs P; __device__ void operator()(int m, int n, float acc) const { ((float*)(P.ws + WS_X1))[(size_t)m * D + n] = bf2f(((const bf16*)P.out)[(size_t)m * D + n]) * acc; } };
struct EpiG3b { Ptrs P; __device__ void operator()(int m, int n, float acc) const {
    const float t = ((const float*)(P.ws + WS_X1))[(size_t)m * D + n];
    ((bf16*)(P.ws + WS_MRG))[(size_t)m * D + n] = (bf16)f2bf(t + bf2f(((const bf16*)((const unsigned char*)P.out + 32 * MiB))[(size_t)m * D + n]) * acc); } };
struct EpiG4 { Ptrs P; __device__ void operator()(int m, int n, float acc) const {
    const float* prm = (const float*)(P.ws + OFF_PRM) + cond_of(m) * 6 * D;
    const float v = xrow(P, m)[n] + prm[2 * D + n] * acc;
    ((float*)(P.ws + WS_X1))[(size_t)m * D + n] = v;
    ((bf16*)(P.ws + WS_X1B))[(size_t)m * D + n] = (bf16)f2bf(v * prm[4 * D + n]); } };
struct EpiG6 { Ptrs P; __device__ void operator()(int m, int n, float acc) const {
    const float* prm = (const float*)(P.ws + OFF_PRM) + cond_of(m) * 6 * D;
    P.out[(size_t)m * D + n] = ((const float*)(P.ws + WS_X1))[(size_t)m * D + n] + prm[5 * D + n] * acc; } };
__global__ void n_rowssq(const float* x, float* ssq) {
    const int m = blockIdx.x * 4 + (threadIdx.x >> 6), lane = threadIdx.x & 63;
    float s = 0.f;
    for (int i = 0; i < 16; ++i) { const float v = x[(size_t)m * D + lane + 64 * i]; s += v * v; }
    s = wsum(s);
    if (lane == 0) ssq[m] = s;
}
__global__ void __launch_bounds__(256) n_g5(Ptrs P) {
    __shared__ float As[16][68];
    __shared__ float Bs[16][64];
    __shared__ float Hs[68][64];
    const int t = threadIdx.x, jg = blockIdx.x, r0 = blockIdx.y * 64;
    const bf16* A = (const bf16*)(P.ws + WS_X1B); const bf16* Bt = (const bf16*)(P.ws + WS_WUP);
    const int col = t & 63, rg = t >> 6;
    const int ja0 = jg * 32;
    float acc[17];
#pragma unroll
    for (int i = 0; i < 17; ++i) acc[i] = 0.f;
    for (int k0 = 0; k0 < D; k0 += 16) {
        for (int idx = t; idx < 68 * 16; idx += 256) { const int i = idx >> 4, kk = idx & 15; int r = r0 - 1 + i; r = r < 0 ? 0 : (r > M - 1 ? M - 1 : r); As[kk][i] = bf2f(A[(size_t)r * D + k0 + kk]); }
        for (int idx = t; idx < 64 * 16; idx += 256) { const int c = idx >> 4, kk = idx & 15; const int ja = ja0 + (c & 31); const int rho = (ja >> 7) * 256 + (ja & 127) + (c >= 32 ? 128 : 0); Bs[kk][c] = bf2f(Bt[(size_t)rho * D + k0 + kk]); }
        __syncthreads();
#pragma unroll
        for (int kk = 0; kk < 16; ++kk) { const float b = Bs[kk][col];
#pragma unroll
            for (int i = 0; i < 17; ++i) acc[i] += As[kk][rg * 17 + i] * b; }
        __syncthreads();
    }
    const int seqlen = r0 < MC ? 256 : 4096;
    const int pos0 = r0 < MC ? (r0 & 255) : ((r0 - MC) & 4095);
    const int cond = cond_of(r0);
    const int jn = ja0 + (col & 31) + (col >= 32 ? DFF : 0);
#pragma unroll
    for (int i = 0; i < 17; ++i) {
        const int ii = rg * 17 + i, r = r0 - 1 + ii;
        const bool valid = ii < 66 && !(ii == 0 && pos0 == 0) && !(ii == 65 && pos0 + 63 == seqlen - 1);
        float v = 0.f;
        if (valid) v = rsqrtf(((const float*)(P.ws + OFF_SSQ2))[r] / D + EPS) * acc[i] + ((const float*)(P.ws + OFF_BIASUP))[cond * DIN + jn];
        Hs[ii][col] = v;
    }
    __syncthreads();
    for (int o = t; o < 64 * 32; o += 256) {
        const int orow = o >> 5, oc = o & 31, ja = ja0 + oc, jb = DFF + ja;
        const float a = P.conv_w[ja] * Hs[orow][oc] + P.conv_w[DIN + ja] * Hs[orow + 1][oc] + P.conv_w[2 * DIN + ja] * Hs[orow + 2][oc] + P.conv_b[ja];
        const float b = P.conv_w[jb] * Hs[orow][oc + 32] + P.conv_w[DIN + jb] * Hs[orow + 1][oc + 32] + P.conv_w[2 * DIN + jb] * Hs[orow + 2][oc + 32] + P.conv_b[jb];
        ((bf16*)(P.ws + WS_ACT))[(size_t)(r0 + orow) * DFF + ja] = (bf16)f2bf(silu_f(a) * b);
    }
}
__global__ void n_final(Ptrs P) {
    const int m = blockIdx.x * 4 + (threadIdx.x >> 6), lane = threadIdx.x & 63;
    const float r = rsqrtf(((const float*)(P.ws + OFF_SSQ3))[m] / D + EPS);
    for (int i = 0; i < 16; ++i) { const int k = lane + 64 * i; P.out[(size_t)m * D + k] = P.out[(size_t)m * D + k] * r * P.norm_final[k]; }
}
}

namespace pg8 {
#define PG8_LAS __attribute__((address_space(3)))
typedef unsigned short bf16_t;
typedef short bf16x8 __attribute__((ext_vector_type(8)));
typedef float f32x4 __attribute__((ext_vector_type(4)));
typedef unsigned u32x4 __attribute__((ext_vector_type(4)));
constexpr int BM = 256, BK = 64, HALF = 128, HTB = HALF * BK * 2  , STAGE_BYTES = 8 * HTB, NXCD = 8, WGM = 8;

__host__ __device__ __forceinline__ int lds_byte(int r, int c) { const int st = (r >> 4) * 2 + (c >> 5), rr = r & 15, cc = c & 31, ob = rr * 64 + cc * 2; return st * 1024 + (ob ^ (((ob >> 9) & 1) << 5)); }
__host__ __device__ __forceinline__ void stage_rc(int b, int& R, int& C) { const int st = b / 1024, sb = b % 1024, swz = sb ^ (((sb >> 9) & 1) << 5); R = (st >> 1) * 16 + swz / 64; C = (st & 1) * 32 + (swz % 64) / 2; }
__host__ __device__ __forceinline__ int perm32(int rho) { const int n = rho >> 4, i = rho & 15; return 8 * (i >> 2) + 4 * n + (i & 3); }

struct Unit { int pm, pn; };
struct Gemm { const bf16_t* A; const bf16_t* Bt; int M, N, K; };

struct StaticOrder {
    int nM, nN, nwg, G, c;
    __host__ __device__ void init(int M, int N, int G_, int c_) { nM = M / BM; nN = N / BM; nwg = nM * nN; G = G_; c = c_; }
    __host__ __device__ bool next(int i, Unit& u) const {
        const long L = (long)i * G + c; if (L >= nwg) return false;
        int wgid = (int)L; { const int q = nwg / NXCD, r = nwg % NXCD, xcd = wgid % NXCD, off = wgid / NXCD; wgid = (xcd < r ? xcd * (q + 1) : r * (q + 1) + (xcd - r) * q) + off; }
        const int nig = WGM * nN, gid = wgid / nig, fm = gid * WGM, gsz = (nM - fm) < WGM ? (nM - fm) : WGM;
        u.pm = fm + ((wgid % nig) % gsz); u.pn = (wgid % nig) / gsz; return true;
    }
    __device__ __forceinline__ void a_ready(const Unit&) const {}
    __device__ __forceinline__ void done(const Unit&) const {}
};

typedef unsigned u32x2 __attribute__((ext_vector_type(2)));
__device__ __forceinline__ unsigned cvt_pk_bf16(float lo, float hi) { unsigned r; asm volatile("v_cvt_pk_bf16_f32 %0, %1, %2" : "=v"(r) : "v"(lo), "v"(hi)); return r; }
__device__ __forceinline__ float bflo(unsigned w) { return __builtin_bit_cast(float, w << 16); }
__device__ __forceinline__ float bfhi(unsigned w) { return __builtin_bit_cast(float, w & 0xffff0000u); }
__device__ __forceinline__ float ex2(float x) { return __builtin_amdgcn_exp2f(x); }
__device__ __forceinline__ float rcpf_(float x) { return __builtin_amdgcn_rcpf(x); }
__device__ __forceinline__ float gelu1(float x) { const float z = x * (0.7978845608028654f * 2.f * L::LOG2E) * (1.f + 0.044715f * x * x); return x * rcpf_(1.f + ex2(-z)); }
__device__ __forceinline__ float sigm1(float x) { return rcpf_(1.f + ex2(-x * L::LOG2E)); }
__device__ __forceinline__ float silu1(float x) { return x * rcpf_(1.f + ex2(-x * L::LOG2E)); }
__device__ __forceinline__ u32x2 pk4(f32x4 v) { u32x2 w; w.x = cvt_pk_bf16(v[0], v[1]); w.y = cvt_pk_bf16(v[2], v[3]); return w; }
__device__ __forceinline__ u32x4 pk8(f32x4 a, f32x4 b) { u32x4 w; w.x = cvt_pk_bf16(a[0], a[1]); w.y = cvt_pk_bf16(a[2], a[3]); w.z = cvt_pk_bf16(b[0], b[1]); w.w = cvt_pk_bf16(b[2], b[3]); return w; }

struct EpiG1 {
    static constexpr bool PERM = true, AFTER_DRAIN = false, MID = false;
    L::Ptrs P;
    __device__ __forceinline__ void operator()(f32x4 (&acc)[2][2][4][2], const Unit& u, int wr, int wc, int fr, int fq) const {
        using namespace L;
        const int pn = u.pn, pm = u.pm;
        const bool lat = pm >= 32;
        const int cond = lat ? 1 + ((pm - 32) >> 4) : 0;
        int row0 = pm * 256 + wr * 64 + fr; asm volatile("" : "+v"(row0));
        const float* rstd1 = (const float*)(P.ws + OFF_RSTD1) + row0;
        const float* bias1 = (const float*)(P.ws + OFF_BIAS1) + cond * DIN;
        float* state_k = P.out + (size_t)M * D; float* state_v = state_k + (size_t)MC * 256;
        if (pn < 5) {
            const int gi = 4 * wc + fq, base = gi < 8 ? 4 * gi : 64 + 4 * (gi - 8), fidx = base & 63;
            f32x4 bv[2][2];
#pragma unroll
            for (int bj = 0; bj < 2; ++bj)
#pragma unroll
                for (int n = 0; n < 2; ++n) bv[bj][n] = *(const f32x4*)(bias1 + pn * 256 + bj * 128 + base + 32 * n);
            const float* rope = (const float*)(P.ws + OFF_ROPE);
#pragma unroll
            for (int ai = 0; ai < 2; ++ai)
#pragma unroll
                for (int m = 0; m < 4; ++m) {
                    const int r = row0 + ai * 128 + m * 16;
                    const float rs = rstd1[ai * 128 + m * 16];
                    f32x4 cs = (f32x4){1.f, 1.f, 1.f, 1.f}, sn = (f32x4){0.f, 0.f, 0.f, 0.f};
                    if (lat) {
                        const int t = (r - MC) & 4095; const int pos = base < 64 ? (t >> 6) : (t & 63);
                        const f32x4 t0 = *(const f32x4*)(rope + (pos * 32 + fidx) * 2), t1 = *(const f32x4*)(rope + (pos * 32 + fidx) * 2 + 4);
                        cs = (f32x4){t0[0], t0[2], t1[0], t1[2]}; sn = (f32x4){t0[1], t0[3], t1[1], t1[3]};
                    }
#pragma unroll
                    for (int bj = 0; bj < 2; ++bj) {
                        const f32x4 x1 = acc[ai][bj][m][0] * rs + bv[bj][0], x2 = acc[ai][bj][m][1] * rs + bv[bj][1];
                        f32x4 o1 = x1 * cs - x2 * sn, o2 = x1 * sn + x2 * cs;
                        if (pn < 4) {
                            o1 = o1 * QSCALE; o2 = o2 * QSCALE;
                            bf16* q = (bf16*)(P.ws + WS_Q) + (size_t)r * 1024 + (pn * 2 + bj) * 128 + base;
                            *(u32x2*)q = pk4(o1); *(u32x2*)(q + 32) = pk4(o2);
                        } else {
                            bf16* k = (bf16*)(P.ws + WS_K) + (size_t)r * 256 + bj * 128 + base;
                            *(u32x2*)k = pk4(o1); *(u32x2*)(k + 32) = pk4(o2);
                            if (!lat) { float* sk = state_k + (size_t)r * 256 + bj * 128 + base; *(f32x4*)sk = x1; *(f32x4*)(sk + 32) = x2; }
                        }
                    }
                }
        } else if (pn == 5) {
            f32x4 bv[2][2];
#pragma unroll
            for (int bj = 0; bj < 2; ++bj)
#pragma unroll
                for (int n = 0; n < 2; ++n) bv[bj][n] = *(const f32x4*)(bias1 + C_V + bj * 128 + wc * 32 + 8 * fq + 4 * n);
#pragma unroll
            for (int ai = 0; ai < 2; ++ai)
#pragma unroll
                for (int m = 0; m < 4; ++m) {
                    const int r = row0 + ai * 128 + m * 16;
                    const float rs = rstd1[ai * 128 + m * 16];
#pragma unroll
                    for (int bj = 0; bj < 2; ++bj) {
                        const int c0 = bj * 128 + wc * 32 + 8 * fq;
                        const f32x4 v0 = acc[ai][bj][m][0] * rs + bv[bj][0], v1 = acc[ai][bj][m][1] * rs + bv[bj][1];
                        *(u32x4*)((bf16*)(P.ws + WS_V) + (size_t)r * 256 + c0) = pk8(v0, v1);
                        if (!lat) { float* sv = state_v + (size_t)r * 256 + c0; *(f32x4*)sv = v0; *(f32x4*)(sv + 4) = v1; }
                    }
                }
        } else {
            const int ty = (pn - 6) >> 2;
            bf16* dst = ty == 0 ? (bf16*)(P.ws + WS_U) : ty == 1 ? (bf16*)(P.ws + WS_VG) : ty == 2 ? (bf16*)P.out : (bf16*)((unsigned char*)P.out + 32 * MiB);
            const int cbase = ((pn - 6) & 3) * 256;
            f32x4 bv[2][2];
#pragma unroll
            for (int bj = 0; bj < 2; ++bj)
#pragma unroll
                for (int n = 0; n < 2; ++n) bv[bj][n] = *(const f32x4*)(bias1 + pn * 256 + bj * 128 + wc * 32 + 8 * fq + 4 * n);
#pragma unroll
            for (int ai = 0; ai < 2; ++ai)
#pragma unroll
                for (int m = 0; m < 4; ++m) {
                    const int r = row0 + ai * 128 + m * 16;
                    const float rs = rstd1[ai * 128 + m * 16];
#pragma unroll
                    for (int bj = 0; bj < 2; ++bj) {
                        const int c0 = cbase + bj * 128 + wc * 32 + 8 * fq;
                        f32x4 v0 = acc[ai][bj][m][0] * rs + bv[bj][0], v1 = acc[ai][bj][m][1] * rs + bv[bj][1];
                        if (ty < 2) {
#pragma unroll
                            for (int j = 0; j < 4; ++j) { v0[j] = gelu1(v0[j]); v1[j] = gelu1(v1[j]); }
                        } else {
#pragma unroll
                            for (int j = 0; j < 4; ++j) { v0[j] = sigm1(v0[j]); v1[j] = sigm1(v1[j]); }
                        }
                        *(u32x4*)(dst + (size_t)r * 1024 + c0) = pk8(v0, v1);
                    }
                }
        }
    }
};

struct EpiG3 {
    static constexpr bool PERM = true, AFTER_DRAIN = false, MID = true;
    const bf16_t* SGA; const bf16_t* SGG; bf16_t* MRG;
    __device__ __forceinline__ void mid(f32x4 (&acc)[2][2][4][2], const Unit& u, int wr, int wc, int fr, int fq) const {
        int row0 = u.pm * 256 + wr * 64 + fr; asm volatile("" : "+v"(row0));
#pragma unroll
        for (int ai = 0; ai < 2; ++ai)
#pragma unroll
            for (int m = 0; m < 4; ++m)
#pragma unroll
                for (int bj = 0; bj < 2; ++bj) {
                    const size_t off = (size_t)(row0 + ai * 128 + m * 16) * 1024 + u.pn * 256 + bj * 128 + wc * 32 + 8 * fq;
                    const u32x4 a = *(const u32x4*)(SGA + off), g = *(const u32x4*)(SGG + off);
#pragma unroll
                    for (int n = 0; n < 2; ++n) {
                        const unsigned a0 = n ? a.z : a.x, a1 = n ? a.w : a.y, g0 = n ? g.z : g.x, g1 = n ? g.w : g.y;
                        f32x4 rt;
                        rt[0] = bflo(a0) * rcpf_(fmaxf(bflo(g0), 1e-30f)); rt[1] = bfhi(a0) * rcpf_(fmaxf(bfhi(g0), 1e-30f));
                        rt[2] = bflo(a1) * rcpf_(fmaxf(bflo(g1), 1e-30f)); rt[3] = bfhi(a1) * rcpf_(fmaxf(bfhi(g1), 1e-30f));
                        acc[ai][bj][m][n] = acc[ai][bj][m][n] * rt;
                    }
                    if (bj == 1) asm volatile("" ::: "memory");
                }
    }
    __device__ __forceinline__ void operator()(f32x4 (&acc)[2][2][4][2], const Unit& u, int wr, int wc, int fr, int fq) const {
        int row0 = u.pm * 256 + wr * 64 + fr; asm volatile("" : "+v"(row0));
#pragma unroll
        for (int ai = 0; ai < 2; ++ai)
#pragma unroll
            for (int m = 0; m < 4; ++m)
#pragma unroll
                for (int bj = 0; bj < 2; ++bj) {
                    const size_t off = (size_t)(row0 + ai * 128 + m * 16) * 1024 + u.pn * 256 + bj * 128 + wc * 32 + 8 * fq;
                    const u32x4 g = *(const u32x4*)(SGG + off);
                    f32x4 g0 = (f32x4){bflo(g.x), bfhi(g.x), bflo(g.y), bfhi(g.y)}, g1 = (f32x4){bflo(g.z), bfhi(g.z), bflo(g.w), bfhi(g.w)};
                    *(u32x4*)(MRG + off) = pk8(acc[ai][bj][m][0] * g0, acc[ai][bj][m][1] * g1);
                    if (bj == 1) asm volatile("" ::: "memory");
                }
    }
};

template <int WHICH> struct EpiRes {
    static constexpr bool PERM = true, AFTER_DRAIN = false, MID = false;
    L::Ptrs P;
    __device__ __forceinline__ void operator()(f32x4 (&acc)[2][2][4][2], const Unit& u, int wr, int wc, int fr, int fq) const {
        using namespace L;
        const int pn = u.pn, pm = u.pm;
        const bool lat = pm >= 32;
        const int cond = lat ? 1 + ((pm - 32) >> 4) : 0;
        int row0 = pm * 256 + wr * 64 + fr; asm volatile("" : "+v"(row0));
        const float* prm = (const float*)(P.ws + OFF_PRM) + cond * 6 * D;
        const int cb = pn * 256 + wc * 32 + 8 * fq;
        f32x4 gv[2][2], sv[2][2];
#pragma unroll
        for (int bj = 0; bj < 2; ++bj)
#pragma unroll
            for (int n = 0; n < 2; ++n) {
                gv[bj][n] = *(const f32x4*)(prm + (WHICH ? 5 : 2) * D + cb + bj * 128 + 4 * n);
                if (WHICH == 0) sv[bj][n] = *(const f32x4*)(prm + 4 * D + cb + bj * 128 + 4 * n);
            }
        const float* base = WHICH == 0 ? (lat ? P.x_sample - (size_t)MC * D : P.x_prompt) : (const float*)(P.ws + WS_X1);
        float* outp = WHICH == 0 ? (float*)(P.ws + WS_X1) : P.out;
        float* ssq = (float*)(P.ws + (WHICH == 0 ? OFF_SSQ2 : OFF_SSQ3));
#pragma unroll
        for (int ai = 0; ai < 2; ++ai)
#pragma unroll
            for (int m = 0; m < 4; ++m) {
                const int r = row0 + ai * 128 + m * 16;
                float ss = 0.f;
#pragma unroll
                for (int bj = 0; bj < 2; ++bj) {
                    const size_t off = (size_t)r * D + cb + bj * 128;
                    const f32x4 b0 = *(const f32x4*)(base + off), b1 = *(const f32x4*)(base + off + 4);
                    const f32x4 v0 = b0 + gv[bj][0] * acc[ai][bj][m][0], v1 = b1 + gv[bj][1] * acc[ai][bj][m][1];
                    *(f32x4*)(outp + off) = v0; *(f32x4*)(outp + off + 4) = v1;
                    if (WHICH == 0) *(u32x4*)((bf16*)(P.ws + WS_X1B) + off) = pk8(v0 * sv[bj][0], v1 * sv[bj][1]);
                    ss += (v0[0] * v0[0] + v0[1] * v0[1]) + (v0[2] * v0[2] + v0[3] * v0[3]) + (v1[0] * v1[0] + v1[1] * v1[1]) + (v1[2] * v1[2] + v1[3] * v1[3]);
                }
                ss += __shfl_xor(ss, 16); ss += __shfl_xor(ss, 32);
                if (fq == 0) atomicAdd(ssq + r, ss);
            }
    }
};

struct EpiG5 {
    static constexpr bool PERM = true, AFTER_DRAIN = false, MID = false;
    L::Ptrs P; PG8_LAS float* hal;
    __device__ __forceinline__ void operator()(f32x4 (&acc)[2][2][4][2], const Unit& u, int wr, int wc, int fr, int fq) const {
        using namespace L;
        const int pn = u.pn, pm = u.pm;
        const bool lat = pm >= 32;
        const int cond = lat ? 1 + ((pm - 32) >> 4) : 0;
        int row0 = pm * 256 + wr * 64 + fr; asm volatile("" : "+v"(row0));
        const float* ssq2 = (const float*)(P.ws + OFF_SSQ2) + row0;
        const float* biasup = (const float*)(P.ws + OFF_BIASUP) + cond * DIN;
        int tc0 = wc * 32 + 8 * fq; asm volatile("" : "+v"(tc0)); const int ja0 = pn * 128 + tc0;
        {
            f32x4 bv[2][2];
#pragma unroll
            for (int bj = 0; bj < 2; ++bj)
#pragma unroll
                for (int n = 0; n < 2; ++n) bv[bj][n] = *(const f32x4*)(biasup + bj * DFF + ja0 + 4 * n);
#pragma unroll
            for (int ai = 0; ai < 2; ++ai)
#pragma unroll
                for (int m = 0; m < 4; ++m) {
                    const float rs = __builtin_amdgcn_rsqf(ssq2[ai * 128 + m * 16] * (1.f / D) + EPS);
#pragma unroll
                    for (int bj = 0; bj < 2; ++bj)
#pragma unroll
                        for (int n = 0; n < 2; ++n) acc[ai][bj][m][n] = acc[ai][bj][m][n] * rs + bv[bj][n];
                }
        }
#pragma unroll
        for (int ai = 0; ai < 2; ++ai) {
            const int s = 2 * ai + wr;
            if (fr == 0) {
#pragma unroll
                for (int bj = 0; bj < 2; ++bj)
#pragma unroll
                    for (int n = 0; n < 2; ++n) *(PG8_LAS f32x4*)(hal + (s * 2 + 0) * 256 + bj * 128 + tc0 + 4 * n) = acc[ai][bj][0][n];
            }
            if (fr == 15) {
#pragma unroll
                for (int bj = 0; bj < 2; ++bj)
#pragma unroll
                    for (int n = 0; n < 2; ++n) *(PG8_LAS f32x4*)(hal + (s * 2 + 1) * 256 + bj * 128 + tc0 + 4 * n) = acc[ai][bj][3][n];
            }
        }
        if (lat) {
            float* side = (float*)(P.ws + WS_SIDE) + (size_t)(pm - 32) * 4 * DIN + pn * 256;
            if (wr == 0 && fr < 2) {
#pragma unroll
                for (int bj = 0; bj < 2; ++bj)
#pragma unroll
                    for (int n = 0; n < 2; ++n) *(f32x4*)(side + fr * DIN + bj * 128 + tc0 + 4 * n) = acc[0][bj][0][n];
            }
            if (wr == 1 && fr >= 14) {
#pragma unroll
                for (int bj = 0; bj < 2; ++bj)
#pragma unroll
                    for (int n = 0; n < 2; ++n) *(f32x4*)(side + (fr - 12) * DIN + bj * 128 + tc0 + 4 * n) = acc[1][bj][3][n];
            }
        }
        asm volatile("s_waitcnt lgkmcnt(0)" ::: "memory"); __builtin_amdgcn_s_barrier(); asm volatile("" ::: "memory");
        const int lane = threadIdx.x & 63;
        const int up_src = (lane & 48) | ((fr + 15) & 15), dn_src = (lane & 48) | ((fr + 1) & 15);
        bf16* ACT = (bf16*)(P.ws + WS_ACT);
#pragma unroll
        for (int n = 0; n < 2; ++n) {
#pragma unroll
            for (int ai = 0; ai < 2; ++ai) {
                const int s = 2 * ai + wr;
                f32x4 cv[2][4];
#pragma unroll
                for (int bj = 0; bj < 2; ++bj) {
                    asm volatile("" ::: "memory");
                    const int col = bj * DFF + ja0 + 4 * n;
                    const f32x4 cw0 = *(const f32x4*)(P.conv_w + col), cw1 = *(const f32x4*)(P.conv_w + DIN + col), cw2 = *(const f32x4*)(P.conv_w + 2 * DIN + col), cbv = *(const f32x4*)(P.conv_b + col);
                    const f32x4 ht = s > 0 ? *(const PG8_LAS f32x4*)(hal + ((s - 1) * 2 + 1) * 256 + bj * 128 + tc0 + 4 * n) : (f32x4){0.f, 0.f, 0.f, 0.f};
                    const f32x4 hb = s < 3 ? *(const PG8_LAS f32x4*)(hal + ((s + 1) * 2 + 0) * 256 + bj * 128 + tc0 + 4 * n) : (f32x4){0.f, 0.f, 0.f, 0.f};
#pragma unroll
                    for (int j = 0; j < 4; ++j) {
                        float X[4], Ru[4], Rd[4];
#pragma unroll
                        for (int m = 0; m < 4; ++m) { X[m] = acc[ai][bj][m][n][j]; Ru[m] = __shfl(X[m], up_src); Rd[m] = __shfl(X[m], dn_src); }
#pragma unroll
                        for (int m = 0; m < 4; ++m) {
                            const float upv = fr > 0 ? Ru[m] : (m > 0 ? Ru[m > 0 ? m - 1 : 0] : ht[j]);
                            const float dnv = fr < 15 ? Rd[m] : (m < 3 ? Rd[m < 3 ? m + 1 : 3] : hb[j]);
                            cv[bj][m][j] = cw0[j] * upv + cw1[j] * X[m] + cw2[j] * dnv + cbv[j];
                        }
                    }
                    asm volatile("" : "+v"(cv[bj][0]), "+v"(cv[bj][1]), "+v"(cv[bj][2]), "+v"(cv[bj][3]));
                }
#pragma unroll
                for (int m = 0; m < 4; ++m) {
                    f32x4 o;
#pragma unroll
                    for (int j = 0; j < 4; ++j) o[j] = silu1(cv[0][m][j]) * cv[1][m][j];
                    *(u32x2*)(ACT + (size_t)(row0 + ai * 128 + m * 16) * DFF + ja0 + 4 * n) = pk4(o);
                }
            }
        }
    }
};
template <class Epi, class Sched, bool ALIGN_EPI = false, bool SP2 = false>
__device__ __forceinline__ void gemm_phase(PG8_LAS unsigned char* lds, const Gemm g, const Sched& S, const Epi& E) {
    const int tid = threadIdx.x, wid = __builtin_amdgcn_readfirstlane(tid >> 6), lane = tid & 63, wr = wid >> 2, wc = wid & 3, fr = lane & 15, fq = lane >> 4;
    const int K = g.K, nt = K / BK;
    unsigned voffA[2], voffB[2];
#pragma unroll
    for (int i = 0; i < 2; ++i) { int R, C; stage_rc(tid * 16 + i * 8192, R, C); const int Rb = Epi::PERM ? ((R & ~31) + perm32(R & 31)) : R;
        voffA[i] = (unsigned)(R * K + C) * 2u; voffB[i] = (unsigned)(Rb * K + C) * 2u; }
    const size_t kstep = (size_t)(BK * 2);
    const size_t hstep = (size_t)HALF * K * 2;
    const size_t tstep = 2 * hstep;
    const unsigned ldsw = (unsigned)wid * 1024u;
    const int aoff = lds_byte(wr * 64 + fr, fq * 8), boff = lds_byte(wc * 32 + fr, fq * 8);
#define PG8_SA(b, h) (((b) * 2 + (h)) * HTB)
#define PG8_SB(b, h) ((4 + (b) * 2 + (h)) * HTB)
#define PG8_STAGE(bufoff, gbase, voff) do { _Pragma("unroll") for (int _i = 0; _i < 2; ++_i) \
        __builtin_amdgcn_global_load_lds((const unsigned*)((const char*)(gbase) + (voff)[_i]), (PG8_LAS unsigned*)(lds + (bufoff) + ldsw + _i * 8192), 16, 0, 0); } while (0)
#define PG8_LDA(dst, b, h) do { _Pragma("unroll") for (int m = 0; m < 4; ++m) _Pragma("unroll") for (int k = 0; k < 2; ++k) dst[m][k] = *(const PG8_LAS bf16x8*)(lds + PG8_SA(b, h) + aoff + m * 2048 + k * 1024); } while (0)
#define PG8_LDB(dst, b, h) do { _Pragma("unroll") for (int n = 0; n < 2; ++n) _Pragma("unroll") for (int k = 0; k < 2; ++k) dst[n][k] = *(const PG8_LAS bf16x8*)(lds + PG8_SB(b, h) + boff + n * 2048 + k * 1024); } while (0)
#define PG8_MMA(ai, bj, At, Bt) do { __builtin_amdgcn_s_setprio(1); _Pragma("unroll") for (int m = 0; m < 4; ++m) _Pragma("unroll") for (int n = 0; n < 2; ++n) _Pragma("unroll") for (int k = 0; k < 2; ++k) \
        acc[ai][bj][m][n] = __builtin_amdgcn_mfma_f32_16x16x32_bf16(Bt[n][k], At[m][k], acc[ai][bj][m][n], 0, 0, 0); __builtin_amdgcn_s_setprio(0); } while (0)
#define PG8_WAIT_V(n) asm volatile("s_waitcnt vmcnt(" #n ")" ::: "memory")
#define PG8_WAIT_L(n) asm volatile("s_waitcnt lgkmcnt(" #n ")" ::: "memory")
#define PG8_BAR __builtin_amdgcn_s_barrier()
#define PG8_SCHED __builtin_amdgcn_sched_barrier(0)
    Unit cur, nxt; int ui = 0;
    if (!S.next(0, cur)) return;
    f32x4 acc[2][2][4][2];
#pragma unroll
    for (int a = 0; a < 2; ++a)
#pragma unroll
        for (int b = 0; b < 2; ++b)
#pragma unroll
            for (int m = 0; m < 4; ++m)
#pragma unroll
                for (int n = 0; n < 2; ++n) acc[a][b][m][n] = (f32x4){0.f, 0.f, 0.f, 0.f};
    bf16x8 At[4][2], B0[2][2], B1[2][2];
    const char* cA = (const char*)g.A + (size_t)cur.pm * tstep; const char* cB = (const char*)g.Bt + (size_t)cur.pn * tstep;
    S.a_ready(cur);
    if constexpr (SP2) {
        PG8_STAGE(PG8_SB(0, 0), cB, voffB); PG8_STAGE(PG8_SB(0, 1), cB + hstep, voffB); PG8_STAGE(PG8_SA(0, 0), cA, voffA); PG8_STAGE(PG8_SA(0, 1), cA + hstep, voffA);
        if (wr == 1) PG8_BAR;
        PG8_WAIT_V(2); PG8_BAR;
        PG8_STAGE(PG8_SB(1, 0), cB + kstep, voffB); PG8_STAGE(PG8_SA(1, 0), cA + kstep, voffA); PG8_STAGE(PG8_SB(1, 1), cB + hstep + kstep, voffB);
        PG8_WAIT_V(6); PG8_BAR;
    } else {
        PG8_STAGE(PG8_SB(0, 0), cB, voffB); PG8_STAGE(PG8_SA(0, 0), cA, voffA); PG8_STAGE(PG8_SB(0, 1), cB + hstep, voffB); PG8_STAGE(PG8_SA(0, 1), cA + hstep, voffA);
        if (wr == 1) PG8_BAR;
        PG8_WAIT_V(4); PG8_BAR;
        PG8_STAGE(PG8_SB(1, 0), cB + kstep, voffB); PG8_STAGE(PG8_SA(1, 0), cA + kstep, voffA); PG8_STAGE(PG8_SB(1, 1), cB + hstep + kstep, voffB);
        PG8_WAIT_V(6); PG8_BAR;
    }
    for (;;) {
        const bool has_next = S.next(ui + 1, nxt);
        const char* nA = has_next ? (const char*)g.A + (size_t)nxt.pm * tstep : cA; const char* nB = has_next ? (const char*)g.Bt + (size_t)nxt.pn * tstep : cB;
        for (int t = 0; t < nt; t += 2) {
            if constexpr (Epi::MID) { if (t == (nt >> 1)) E.mid(acc, cur, wr, wc, fr, fq); }
            const bool last = (t == nt - 2);
            const char* a1 = cA + (size_t)(t + 1) * kstep;
            const char* a2 = last ? nA : cA + (size_t)(t + 2) * kstep; const char* b2 = last ? nB : cB + (size_t)(t + 2) * kstep;
            const char* a3 = a2 + kstep; const char* b3 = b2 + kstep;
            if (last && has_next) S.a_ready(nxt);
            if constexpr (SP2) {
            PG8_LDB(B0, 0, 0); PG8_LDB(B1, 0, 1); PG8_SCHED; PG8_LDA(At, 0, 0); PG8_STAGE(PG8_SA(1, 1), a1 + hstep, voffA);
            PG8_WAIT_V(8); PG8_WAIT_L(0); PG8_BAR; PG8_MMA(0, 0, At, B0); PG8_MMA(0, 1, At, B1); PG8_BAR; PG8_SCHED;
            PG8_LDA(At, 0, 1); PG8_STAGE(PG8_SB(0, 0), b2, voffB); PG8_STAGE(PG8_SB(0, 1), b2 + hstep, voffB); PG8_STAGE(PG8_SA(0, 0), a2, voffA);
            PG8_WAIT_V(8); PG8_WAIT_L(0); PG8_BAR; PG8_MMA(1, 0, At, B0); PG8_MMA(1, 1, At, B1); PG8_BAR; PG8_SCHED;
            PG8_LDB(B0, 1, 0); PG8_LDB(B1, 1, 1); PG8_SCHED; PG8_LDA(At, 1, 0); PG8_STAGE(PG8_SA(0, 1), a2 + hstep, voffA);
            PG8_WAIT_V(8); PG8_WAIT_L(0); PG8_BAR; PG8_MMA(0, 0, At, B0); PG8_MMA(0, 1, At, B1); PG8_BAR; PG8_SCHED;
            PG8_LDA(At, 1, 1); PG8_STAGE(PG8_SB(1, 0), b3, voffB); PG8_STAGE(PG8_SB(1, 1), b3 + hstep, voffB); PG8_STAGE(PG8_SA(1, 0), a3, voffA);
            PG8_WAIT_V(8); PG8_WAIT_L(0); PG8_BAR; PG8_MMA(1, 0, At, B0); PG8_MMA(1, 1, At, B1); PG8_BAR; PG8_SCHED;
            } else {
            PG8_LDB(B0, 0, 0); PG8_SCHED; PG8_LDA(At, 0, 0); PG8_STAGE(PG8_SA(1, 1), a1 + hstep, voffA);
            PG8_WAIT_L(8); PG8_BAR; PG8_WAIT_L(0); PG8_MMA(0, 0, At, B0); PG8_BAR; PG8_SCHED;
            PG8_LDB(B1, 0, 1); PG8_STAGE(PG8_SB(0, 0), b2, voffB);
            PG8_BAR; PG8_WAIT_L(0); PG8_MMA(0, 1, At, B1); PG8_BAR;
            PG8_LDA(At, 0, 1); PG8_STAGE(PG8_SA(0, 0), a2, voffA);
            PG8_BAR; PG8_WAIT_L(0); PG8_MMA(1, 0, At, B0); PG8_BAR; PG8_SCHED;
            PG8_STAGE(PG8_SB(0, 1), b2 + hstep, voffB);
            PG8_WAIT_V(6); PG8_BAR; PG8_MMA(1, 1, At, B1); PG8_BAR;
            PG8_LDB(B0, 1, 0); PG8_SCHED; PG8_LDA(At, 1, 0); PG8_STAGE(PG8_SA(0, 1), a2 + hstep, voffA);
            PG8_WAIT_L(8); PG8_BAR; PG8_WAIT_L(0); PG8_MMA(0, 0, At, B0); PG8_BAR; PG8_SCHED;
            PG8_LDB(B1, 1, 1); PG8_STAGE(PG8_SB(1, 0), b3, voffB);
            PG8_BAR; PG8_WAIT_L(0); PG8_MMA(0, 1, At, B1); PG8_BAR;
            PG8_LDA(At, 1, 1); PG8_STAGE(PG8_SA(1, 0), a3, voffA);
            PG8_BAR; PG8_WAIT_L(0); PG8_MMA(1, 0, At, B0); PG8_BAR; PG8_SCHED;
            PG8_STAGE(PG8_SB(1, 1), b3 + hstep, voffB);
            PG8_WAIT_V(6); PG8_BAR; PG8_MMA(1, 1, At, B1); PG8_BAR;
            }
        }
        if constexpr (ALIGN_EPI) { if (wr == 0) PG8_BAR; }
        if constexpr (!Epi::AFTER_DRAIN) { E(acc, cur, wr, wc, fr, fq); S.done(cur); }
        if (!has_next) break;
#pragma unroll
        for (int a = 0; a < 2; ++a)
#pragma unroll
            for (int b = 0; b < 2; ++b)
#pragma unroll
                for (int m = 0; m < 4; ++m)
#pragma unroll
                    for (int n = 0; n < 2; ++n) acc[a][b][m][n] = (f32x4){0.f, 0.f, 0.f, 0.f};
        cur = nxt; cA = nA; cB = nB; ++ui;
        if constexpr (ALIGN_EPI) { if (wr == 1) PG8_BAR; }
    }
    PG8_WAIT_V(0);
    if constexpr (!ALIGN_EPI) { if (wr == 0) PG8_BAR; }
    PG8_BAR;
    if constexpr (Epi::AFTER_DRAIN) { E.fused(acc, cur, wr, wc, fr, fq, lds, wid, lane); S.done(cur); }
#undef PG8_SA
#undef PG8_SB
#undef PG8_STAGE
#undef PG8_LDA
#undef PG8_LDB
#undef PG8_MMA
#undef PG8_WAIT_V
#undef PG8_WAIT_L
#undef PG8_BAR
#undef PG8_SCHED
}
}

namespace at {
using namespace L;
#define LAS __attribute__((address_space(3)))
typedef short bf16x8 __attribute__((ext_vector_type(8)));
typedef short s16x4 __attribute__((ext_vector_type(4)));
typedef float f32x16 __attribute__((ext_vector_type(16)));
typedef float f32x4 __attribute__((ext_vector_type(4)));
typedef unsigned u32x4 __attribute__((ext_vector_type(4)));
constexpr int KSTR = 272, VSTR = 136, KBUF = 64 * KSTR, VBUF = 128 * VSTR, BUF = KBUF + VBUF, SCR_OFF = 2 * BUF;
constexpr int ATT_LDS = SCR_OFF + 8 * 256;
constexpr int NOMASK = -1000000;
__device__ __forceinline__ int crow(int r, int hi) { return (r & 3) + 8 * (r >> 2) + 4 * hi; }
__device__ __forceinline__ unsigned pkbf(float lo, float hi) { unsigned r; asm volatile("v_cvt_pk_bf16_f32 %0, %1, %2" : "=v"(r) : "v"(lo), "v"(hi)); return r; }
#define AT_BAR() do { asm volatile("s_waitcnt vmcnt(0) lgkmcnt(0)" ::: "memory"); __builtin_amdgcn_s_barrier(); asm volatile("" ::: "memory"); } while (0)
#define AT_LWAIT() asm volatile("s_waitcnt lgkmcnt(0)" ::: "memory")

__device__ __forceinline__ void attn_unit(LAS unsigned char* lds, const Ptrs& P, int kind, int b, int kvh, int p0) {
    const int tid = threadIdx.x, lane = tid & 63, r32 = lane & 31, hi = lane >> 5; const int wid = __builtin_amdgcn_readfirstlane(tid >> 6);
    const int seqbase = kind == 0 ? b * 256 : MC + b * 4096;
    const int head = kvh * 4 + (wid >> 1), a = p0 + 32 * (wid & 1);
    const bf16* Qb = (const bf16*)(P.ws + WS_Q); const bf16* Kb = (const bf16*)(P.ws + WS_K); const bf16* Vb = (const bf16*)(P.ws + WS_V);
    const bf16* CK = (const bf16*)(P.ws + WS_CK); const bf16* CV = (const bf16*)(P.ws + WS_CV);
    bf16x8 qf[8];
    {
        const bf16* qp = Qb + (size_t)(seqbase + a + r32) * 1024 + head * 128 + 8 * hi;
#pragma unroll
        for (int s = 0; s < 8; ++s) qf[s] = *(const bf16x8*)(qp + 16 * s);
    }
    float m_run = P.sink[head] * LOG2E, l_run = hi == 0 ? 1.f : 0.f;
    f32x16 o[4];
#pragma unroll
    for (int d = 0; d < 4; ++d)
#pragma unroll
        for (int r = 0; r < 16; ++r) o[d][r] = 0.f;
    LAS float* scr = (LAS float*)(lds + SCR_OFF) + wid * 64;
    int tb = 4, te = 4;
    if (kind == 1) { tb = 4 + (p0 < 128 ? (128 - p0) >> 6 : 0); te = 9 - (p0 + 192 > 4096 ? (p0 + 192 - 4096) >> 6 : 0); }
    const int ntile = 4 + (te - tb);
    u32x4 kr[2], vr[2];
#define AT_TILE(i, kp, vp, pos) do { const int t_ = (i) < 4 ? (i) : tb + (i) - 4; \
        if (kind == 0) { kp = Kb + (size_t)(seqbase + 64 * t_) * 256 + kvh * 128; vp = Vb + (size_t)(seqbase + 64 * t_) * 256 + kvh * 128; pos = NOMASK; } \
        else if (t_ < 4) { kp = CK + (size_t)(b * 256 + 64 * t_) * 256 + kvh * 128; vp = CV + (size_t)(b * 256 + 64 * t_) * 256 + kvh * 128; pos = NOMASK; } \
        else { pos = p0 - 128 + 64 * (t_ - 4); kp = Kb + (size_t)(seqbase + pos) * 256 + kvh * 128; vp = Vb + (size_t)(seqbase + pos) * 256 + kvh * 128; } } while (0)
#define AT_LOAD(i) do { const bf16* kp_; const bf16* vp_; int pos_; AT_TILE(i, kp_, vp_, pos_); (void)pos_; \
        _Pragma("unroll") for (int i_ = 0; i_ < 2; ++i_) { const int c_ = tid + 512 * i_; kr[i_] = *(const u32x4*)(kp_ + (size_t)(c_ >> 4) * 256 + (c_ & 15) * 8); vr[i_] = *(const u32x4*)(vp_ + (size_t)(c_ >> 4) * 256 + (c_ & 15) * 8); } } while (0)
#define AT_WRITE(buf) do { _Pragma("unroll") for (int i_ = 0; i_ < 2; ++i_) { const int c_ = tid + 512 * i_, key_ = c_ >> 4, dc_ = c_ & 15; \
        *(LAS u32x4*)(lds + (buf) * BUF + key_ * KSTR + dc_ * 16) = kr[i_]; \
        LAS unsigned short* vt_ = (LAS unsigned short*)(lds + (buf) * BUF + KBUF) + (dc_ * 8) * (VSTR / 2) + key_; \
        vt_[0 * (VSTR / 2)] = (unsigned short)(vr[i_].x & 0xffffu); vt_[1 * (VSTR / 2)] = (unsigned short)(vr[i_].x >> 16); \
        vt_[2 * (VSTR / 2)] = (unsigned short)(vr[i_].y & 0xffffu); vt_[3 * (VSTR / 2)] = (unsigned short)(vr[i_].y >> 16); \
        vt_[4 * (VSTR / 2)] = (unsigned short)(vr[i_].z & 0xffffu); vt_[5 * (VSTR / 2)] = (unsigned short)(vr[i_].z >> 16); \
        vt_[6 * (VSTR / 2)] = (unsigned short)(vr[i_].w & 0xffffu); vt_[7 * (VSTR / 2)] = (unsigned short)(vr[i_].w >> 16); } } while (0)
    AT_LOAD(0); AT_WRITE(0); AT_BAR();
    for (int i = 0; i < ntile; ++i) {
        const int cur = i & 1;
        if (i + 1 < ntile) AT_LOAD(i + 1);
        int pos;
        { const bf16* kp_; const bf16* vp_; AT_TILE(i, kp_, vp_, pos); (void)kp_; (void)vp_; }
#pragma unroll
        for (int sb = 0; sb < 2; ++sb) {
            const int kb = pos + 32 * sb;
            bool proc = true, masked = false;
            if (pos != NOMASK) { const int dlt = kb - a; proc = dlt >= -128 && dlt <= 128; masked = dlt == -128 || dlt == 128; }
            if (proc) {
                f32x16 p;
#pragma unroll
                for (int r = 0; r < 16; ++r) p[r] = 0.f;
                const LAS unsigned char* kl = lds + cur * BUF + (32 * sb + r32) * KSTR + hi * 16;
#pragma unroll
                for (int s = 0; s < 8; ++s) { const bf16x8 kf = *(const LAS bf16x8*)(kl + s * 32); p = __builtin_amdgcn_mfma_f32_32x32x16_bf16(kf, qf[s], p, 0, 0, 0); }
                if (masked) {
#pragma unroll
                    for (int r = 0; r < 16; ++r) { const int dd = kb + crow(r, hi) - (a + r32); if (dd < -128 || dd > 128) p[r] = -1e30f; }
                }
                float mx = p[0];
#pragma unroll
                for (int r = 1; r < 16; ++r) mx = fmaxf(mx, p[r]);
                mx = fmaxf(mx, __shfl_xor(mx, 32));
                if (__any(mx > m_run)) {
                    const float mn = fmaxf(m_run, mx), f = __builtin_amdgcn_exp2f(m_run - mn);
                    l_run *= f; m_run = mn;
                    if (hi == 0) scr[r32] = f;
                    AT_LWAIT();
#pragma unroll
                    for (int r = 0; r < 16; ++r) { const float fr_ = scr[crow(r, hi)];
#pragma unroll
                        for (int d = 0; d < 4; ++d) o[d][r] *= fr_; }
                    AT_LWAIT();
                }
                float ls = 0.f;
#pragma unroll
                for (int r = 0; r < 16; ++r) { p[r] = __builtin_amdgcn_exp2f(p[r] - m_run); ls += p[r]; }
                l_run += ls;
                u32x4 pw0, pw1;
                pw0.x = pkbf(p[0], p[1]); pw0.y = pkbf(p[2], p[3]); pw0.z = pkbf(p[4], p[5]); pw0.w = pkbf(p[6], p[7]);
                pw1.x = pkbf(p[8], p[9]); pw1.y = pkbf(p[10], p[11]); pw1.z = pkbf(p[12], p[13]); pw1.w = pkbf(p[14], p[15]);
                const bf16x8 pa0 = __builtin_bit_cast(bf16x8, pw0), pa1 = __builtin_bit_cast(bf16x8, pw1);
                const LAS unsigned char* vl = lds + cur * BUF + KBUF + r32 * VSTR + (32 * sb + 4 * hi) * 2;
#pragma unroll
                for (int d = 0; d < 4; ++d) {
                    const s16x4 l0 = *(const LAS s16x4*)(vl + d * 32 * VSTR), h0 = *(const LAS s16x4*)(vl + d * 32 * VSTR + 16);
                    const s16x4 l1 = *(const LAS s16x4*)(vl + d * 32 * VSTR + 32), h1 = *(const LAS s16x4*)(vl + d * 32 * VSTR + 48);
                    const bf16x8 v0 = (bf16x8){l0[0], l0[1], l0[2], l0[3], h0[0], h0[1], h0[2], h0[3]};
                    const bf16x8 v1 = (bf16x8){l1[0], l1[1], l1[2], l1[3], h1[0], h1[1], h1[2], h1[3]};
                    o[d] = __builtin_amdgcn_mfma_f32_32x32x16_bf16(pa0, v0, o[d], 0, 0, 0);
                    o[d] = __builtin_amdgcn_mfma_f32_32x32x16_bf16(pa1, v1, o[d], 0, 0, 0);
                }
            }
        }
        if (i + 1 < ntile) AT_WRITE(cur ^ 1);
        AT_BAR();
    }
    {
        const float lt = l_run + __shfl_xor(l_run, 32);
        if (hi == 0) scr[r32] = 1.f / lt;
        AT_LWAIT();
        LAS unsigned short* stg = (LAS unsigned short*)(lds + wid * 8704);
#pragma unroll
        for (int r = 0; r < 16; ++r) { const int q = crow(r, hi); const float inv = scr[q];
#pragma unroll
            for (int d = 0; d < 4; ++d) stg[q * 136 + 32 * d + r32] = (unsigned short)f2bf(o[d][r] * inv); }
        AT_LWAIT();
        bf16* AG = (bf16*)(P.ws + WS_AG);
#pragma unroll
        for (int i = 0; i < 8; ++i) { const int row = i * 4 + (lane >> 4), ch = lane & 15;
            const u32x4 v = *(const LAS u32x4*)(stg + row * 136 + ch * 8);
            *(u32x4*)(AG + (size_t)(seqbase + a + row) * 2048 + head * 128 + ch * 8) = v; }
    }
    AT_BAR();
#undef AT_TILE
#undef AT_LOAD
#undef AT_WRITE
}

__device__ __forceinline__ void mix_unit(LAS unsigned char* lds, const Ptrs& P, int cn, int g) {
    const int tid = threadIdx.x, lane = tid & 63, r32 = lane & 31, hi = lane >> 5; const int wid = __builtin_amdgcn_readfirstlane(tid >> 6);
    const int r0 = cn * 128;
    const bf16* WSb = (const bf16*)(P.ws + WS_WS) + (size_t)g * 128 * 128;
    const bf16* VG = (const bf16*)(P.ws + WS_VG); const bf16* U = (const bf16*)(P.ws + WS_U); bf16* AG = (bf16*)(P.ws + WS_AG);
#pragma unroll
    for (int i = 0; i < 4; ++i) { const int c = tid + 512 * i, row = c >> 4, ch = c & 15;
        *(LAS u32x4*)(lds + row * 272 + ch * 16) = *(const u32x4*)(WSb + row * 128 + ch * 8); }
    {
        const int q = tid >> 2, part = tid & 3;
        u32x4 v[4]; float ss = 0.f;
#pragma unroll
        for (int i = 0; i < 4; ++i) { v[i] = *(const u32x4*)(VG + (size_t)(r0 + q) * 1024 + g * 128 + (part * 4 + i) * 8);
#pragma unroll
            for (int e = 0; e < 4; ++e) { const unsigned w = v[i][e]; const float lo = __builtin_bit_cast(float, w << 16), hf = __builtin_bit_cast(float, w & 0xffff0000u); ss += lo * lo + hf * hf; } }
        ss += __shfl_xor(ss, 1); ss += __shfl_xor(ss, 2);
        const float rstd = rsqrtf(ss * (1.f / 128.f) + EPS);
        LAS unsigned short* bt = (LAS unsigned short*)(lds + 34816);
#pragma unroll
        for (int i = 0; i < 4; ++i) {
            const int d0 = (part * 4 + i) * 8;
            const f32x4 g0 = *(const f32x4*)(P.gnorm + g * 128 + d0), g1 = *(const f32x4*)(P.gnorm + g * 128 + d0 + 4);
#pragma unroll
            for (int e = 0; e < 4; ++e) { const unsigned w = v[i][e]; const float lo = __builtin_bit_cast(float, w << 16), hf = __builtin_bit_cast(float, w & 0xffff0000u);
                const float gl = e < 2 ? g0[2 * e] : g1[2 * e - 4], gh = e < 2 ? g0[2 * e + 1] : g1[2 * e - 3];
                bt[(d0 + 2 * e) * 136 + q] = (unsigned short)f2bf(lo * rstd * gl); bt[(d0 + 2 * e + 1) * 136 + q] = (unsigned short)f2bf(hf * rstd * gh); }
        }
    }
    AT_BAR();
    const int pb = wid >> 1, dh = wid & 1;
    f32x16 acc[2];
#pragma unroll
    for (int d = 0; d < 2; ++d)
#pragma unroll
        for (int r = 0; r < 16; ++r) acc[d][r] = 0.f;
#pragma unroll
    for (int s = 0; s < 8; ++s) {
        const bf16x8 af = *(const LAS bf16x8*)(lds + (32 * pb + r32) * 272 + (2 * s + hi) * 16);
#pragma unroll
        for (int d = 0; d < 2; ++d) { const bf16x8 bfr = *(const LAS bf16x8*)(lds + 34816 + (64 * dh + 32 * d + r32) * 272 + (2 * s + hi) * 16);
            acc[d] = __builtin_amdgcn_mfma_f32_32x32x16_bf16(af, bfr, acc[d], 0, 0, 0); }
    }
#pragma unroll
    for (int r = 0; r < 16; ++r) {
        const int p = 32 * pb + crow(r, hi); const float bs = P.b_s[g * 128 + p];
#pragma unroll
        for (int d = 0; d < 2; ++d) { const int dd = 64 * dh + 32 * d + r32;
            const float uu = bf2f(U[(size_t)(r0 + p) * 1024 + g * 128 + dd]);
            AG[(size_t)(r0 + p) * 2048 + 1024 + g * 128 + dd] = (bf16)f2bf(uu * (acc[d][r] + bs)); }
    }
    AT_BAR();
}
}

namespace fr {
using namespace L;
#define GAS __attribute__((address_space(1)))
typedef unsigned v4u __attribute__((ext_vector_type(4)));
typedef float f32x4 __attribute__((ext_vector_type(4)));
typedef GAS unsigned gu32;
#define RLX_AGENT __ATOMIC_RELAXED, __HIP_MEMORY_SCOPE_AGENT
#define LDS_WAIT() asm volatile("s_waitcnt lgkmcnt(0)" ::: "memory")
__device__ __forceinline__ unsigned pk2(float lo, float hi) { return f2bf(lo) | (f2bf(hi) << 16); }

#define XB_TMO      128
#define XB_XCNT(j)  (256  + 64 * (j))
#define XB_XSUB(j)  (1280 + 64 * (j))
#define XB_XGEN(j)  (2304 + 64 * (j))
#define XB_TOP      3328
#define XB_TOPGEN   3392
#define XCD_BAR_WORDS 3456
#define XB_SPIN_CAP (1u << 18)
__device__ __forceinline__ unsigned xb_ld(unsigned* p)              { return __hip_atomic_load(p, __ATOMIC_RELAXED, __HIP_MEMORY_SCOPE_AGENT); }
__device__ __forceinline__ unsigned xb_add(unsigned* p, unsigned v) { return __hip_atomic_fetch_add(p, v, __ATOMIC_RELAXED, __HIP_MEMORY_SCOPE_AGENT); }
__device__ __forceinline__ unsigned xb_xcc_id() { return (unsigned)__builtin_amdgcn_s_getreg((3 << 11) | 20) & 0xFu; }
#define XB_SPIN(cond, bar) do { unsigned _sp = 0; while (cond) { __builtin_amdgcn_s_sleep(1); \
    if ((++_sp & 255u) == 0u) { if (xb_ld(&(bar)[XB_TMO])) break; if (_sp > XB_SPIN_CAP) { atomicAdd(&(bar)[XB_TMO], 1u); break; } } } } while (0)
struct XcdBarrier { unsigned* bar; unsigned x; volatile LAS unsigned* st; };
__device__ __forceinline__ XcdBarrier xcd_barrier_post(unsigned* bar, volatile LAS unsigned* st) {
    XcdBarrier b; b.bar = bar; b.x = xb_xcc_id(); b.st = st;
    if (threadIdx.x == 0) (void)xb_add(&bar[XB_XCNT(b.x)], 1u);
    return b;
}
__device__ __forceinline__ void xcd_barrier_complete(unsigned* bar, unsigned x, unsigned& nloc, unsigned& nx) {
    const unsigned G = gridDim.x * gridDim.y * gridDim.z;
    unsigned sum, cnt, mine, sp = 0u;
    for (;;) {
        sum = 0u; cnt = 0u; mine = 0u;
#pragma unroll
        for (unsigned j = 0; j < 16; ++j) { const unsigned c = xb_ld(&bar[XB_XCNT(j)]); sum += c; cnt += (c > 0u) ? 1u : 0u; mine = (j == x) ? c : mine; }
        if (sum == G) break;
        __builtin_amdgcn_s_sleep(1);
        if ((++sp & 255u) == 0u) { if (xb_ld(&bar[XB_TMO])) break; if (sp > XB_SPIN_CAP) { atomicAdd(&bar[XB_TMO], 1u); break; } }
    }
    nloc = mine > 0u ? mine : 1u; nx = cnt > 0u ? cnt : 1u;
}
__device__ __forceinline__ void xcd_barrier(const XcdBarrier& b) {
    asm volatile("s_waitcnt vmcnt(0)" ::: "memory");
    __syncthreads();
    if (threadIdx.x == 0) {
        unsigned* bar = b.bar;
        __builtin_amdgcn_s_waitcnt(0);
        unsigned nloc = b.st[0], nx = b.st[1];
        if (nloc == 0u) { xcd_barrier_complete(bar, b.x, nloc, nx); b.st[0] = nloc; b.st[1] = nx; }
        const unsigned old = xb_add(&bar[XB_XSUB(b.x)], 1u);
        const unsigned gen = old / nloc;
        if (old + 1u == (gen + 1u) * nloc) {
            __builtin_amdgcn_fence(__ATOMIC_RELEASE, "agent");
            asm volatile("s_waitcnt vmcnt(0)" ::: "memory");
            const unsigned og = xb_add(&bar[XB_TOP], 1u);
            const unsigned tg = og / nx;
            if (og + 1u == (tg + 1u) * nx) xb_add(&bar[XB_TOPGEN], 1u);
            else XB_SPIN(xb_ld(&bar[XB_TOPGEN]) == tg, bar);
            __builtin_amdgcn_fence(__ATOMIC_ACQUIRE, "agent");
            xb_add(&bar[XB_XGEN(b.x)], 1u);
            asm volatile("s_waitcnt vmcnt(0)" ::: "memory");
        } else {
            XB_SPIN(xb_ld(&bar[XB_XGEN(b.x)]) == gen, bar);
            __builtin_amdgcn_fence(__ATOMIC_ACQUIRE, "agent");
            asm volatile("s_waitcnt vmcnt(0)" ::: "memory");
        }
    }
    __syncthreads();
}

constexpr int NWAVES = 8;
constexpr int RING_BYTES = 131072, HALO_OFF = RING_BYTES, HALO_BYTES = 8192, LDSCTL_OFF = HALO_OFF + HALO_BYTES, MISC_OFF = LDSCTL_OFF + 320;
constexpr int LDS_BYTES = 147456;
static_assert(MISC_OFF + 128 <= LDS_BYTES && at::ATT_LDS <= RING_BYTES, "LDS map");

__device__ __forceinline__ float wave_sum(float v) {
#pragma unroll
    for (int o = 1; o < 64; o <<= 1) v += __shfl_xor(v, o);
    return v;
}
template <int MODE> __device__ __forceinline__ void transpose_item(const float* W, int K, int N, bf16* WT, int ldd, int koff, LAS float* scr, int item, int lane) {
    const int nblk = N / 32, kb = item / nblk, nb = item % nblk, k0 = 64 * kb, n0 = 32 * nb;
    const int rho = n0 + (lane & 31);
    const int col = MODE == 1 ? sig_in(rho) : MODE == 2 ? sig_up(rho) : rho;
#pragma unroll 8
    for (int i = 0; i < 32; ++i) { const int kk = 2 * i + (lane >> 5); scr[kk * 33 + (lane & 31)] = W[(size_t)(k0 + kk) * N + col]; }
    LDS_WAIT(); asm volatile("" ::: "memory");
    const int c = lane & 7;
#pragma unroll
    for (int j = 0; j < 4; ++j) { const int n = (lane >> 3) + 8 * j; const LAS float* s = scr + (8 * c) * 33 + n;
        v4u o; o.x = pk2(s[0 * 33], s[1 * 33]); o.y = pk2(s[2 * 33], s[3 * 33]); o.z = pk2(s[4 * 33], s[5 * 33]); o.w = pk2(s[6 * 33], s[7 * 33]);
        *(GAS v4u*)(WT + (size_t)(n0 + n) * ldd + koff + k0 + 8 * c) = o; }
    LDS_WAIT(); asm volatile("" ::: "memory");
}
template <int VEC> __device__ __forceinline__ void gemv_item(const Ptrs& P, const float* W, int N, float* out, int item, int lane) {
    const int nnc = N / 256, kc = item / nnc, nc = item % nnc, k0 = kc * 64, n0 = nc * 256 + lane * 4;
    float vl[3];
#pragma unroll
    for (int c = 0; c < 3; ++c) {
        if (VEC == 0) { const float x = (c == 0 ? P.c_ctx : P.c + (c - 1) * D)[k0 + lane]; vl[c] = silu_f(x); }
        else { const int off = VEC == 1 ? 0 : 3 * D; vl[c] = ((const float*)(P.ws + OFF_MVEC))[c * 6 * D + off + k0 + lane] + P.b_ada[off + k0 + lane]; }
    }
    f32x4 acc[3];
#pragma unroll
    for (int c = 0; c < 3; ++c) acc[c] = (f32x4){0.f, 0.f, 0.f, 0.f};
#pragma unroll 8
    for (int kk = 0; kk < 64; ++kk) {
        const f32x4 w = *(const f32x4*)(W + (size_t)(k0 + kk) * N + n0);
#pragma unroll
        for (int c = 0; c < 3; ++c) acc[c] = acc[c] + w * __shfl(vl[c], kk);
    }
#pragma unroll
    for (int c = 0; c < 3; ++c)
#pragma unroll
        for (int j = 0; j < 4; ++j) atomicAdd(out + c * N + n0 + j, acc[c][j]);
}

struct Args { Ptrs P; int lo, hi; };
__global__ void __launch_bounds__(NWAVES * 64, 2) mega(Args args) {
    extern __shared__ __attribute__((aligned(16))) unsigned char lds_raw[];
    LAS unsigned char* lds = (LAS unsigned char*)lds_raw;
    const Ptrs& P = args.P;
    const int tid = threadIdx.x, lane = tid & 63, wave = __builtin_amdgcn_readfirstlane(tid >> 6);
    const int G = gridDim.x, bx = blockIdx.x, vcu = (G % 8 == 0) ? (bx % 8) * (G / 8) + bx / 8 : bx;
    const int gw = vcu * NWAVES + wave, NGW = G * NWAVES;
    unsigned char* ws = P.ws;
    for (int u = tid; u < (LDS_BYTES - LDSCTL_OFF) / 4; u += NWAVES * 64) ((LAS unsigned*)(lds + LDSCTL_OFF))[u] = 0u;
    __syncthreads();
    const int lo = args.lo, hi = args.hi;
    XcdBarrier bar; bar.bar = (unsigned*)(ws + OFF_BAR); bar.x = 0; bar.st = nullptr;
    if (hi - lo > 1) bar = xcd_barrier_post((unsigned*)(ws + OFF_BAR), (volatile LAS unsigned*)(lds + MISC_OFF) + 8);
#ifndef COMPILE_MASK
#define COMPILE_MASK 0x3ff
#endif
#define IN(k) ((((COMPILE_MASK) >> (k)) & 1) && lo <= (k) && (k) < hi)
#define SEAM(k) do { if (IN(k) && IN((k) + 1)) xcd_barrier(bar); } while (0)

    if (IN(0)) {
        LAS float* scr = (LAS float*)(lds + wave * 16384);
        constexpr int I_IN = (D / 64) * (DIN / 32), I_SQ = (D / 64) * (D / 32), I_DN = (DFF / 64) * (D / 32), I_ADA = (D / 64) * (6 * D / 256);
        constexpr int NIT = 2 * I_IN + 3 * I_SQ + I_DN + I_ADA;
        for (int it = gw; it < NIT; it += NGW) {
            int r = it;
            if (r < I_ADA) { gemv_item<0>(P, P.w_ada, 6 * D, (float*)(ws + OFF_MVEC), r, lane); continue; } r -= I_ADA;
            if (r < I_IN) { transpose_item<1>(P.w_in, D, DIN, (bf16*)(ws + WS_WIN), D, 0, scr, r, lane); continue; } r -= I_IN;
            if (r < I_IN) { transpose_item<2>(P.w_up, D, DIN, (bf16*)(ws + WS_WUP), D, 0, scr, r, lane); continue; } r -= I_IN;
            if (r < I_SQ) { transpose_item<0>(P.w_o_attn, D, D, (bf16*)(ws + WS_WCAT), 2048, 0, scr, r, lane); continue; } r -= I_SQ;
            if (r < I_SQ) { transpose_item<0>(P.w_o_gmlp, D, D, (bf16*)(ws + WS_WCAT), 2048, 1024, scr, r, lane); continue; } r -= I_SQ;
            if (r < I_SQ) { transpose_item<0>(P.w_out, D, D, (bf16*)(ws + WS_WOUT), D, 0, scr, r, lane); continue; } r -= I_SQ;
            transpose_item<0>(P.w_down, DFF, D, (bf16*)(ws + WS_WDOWN), DFF, 0, scr, r, lane);
        }
        const int gt = vcu * (NWAVES * 64) + tid, NGT = G * NWAVES * 64;
        for (int i = gt; i < 2 * 256 * 256; i += NGT) {
            if (i < 64 * 32) {
                const int pos = i >> 5, f = i & 31;
                const float inv = exp2f(-(float)f / 32.f * 13.287712379549449f);
                const float ang = (float)pos * inv;
                const double a = (double)ang;
                float* t = (float*)(ws + OFF_ROPE);
                t[2 * i] = (float)cos(a); t[2 * i + 1] = (float)sin(a);
            }
            ((bf16*)(ws + WS_WS))[i] = (bf16)f2bf(P.w_s[i]);
            ((bf16*)(ws + WS_CK))[i] = (bf16)f2bf(P.cache_k[i]); ((bf16*)(ws + WS_CV))[i] = (bf16)f2bf(P.cache_v[i]);
        }
    }
    SEAM(0);
    if (IN(1)) {
        const float* mv = (const float*)(ws + OFF_MVEC);
        {
            const int rows_per = M / NGW;
            const int m0 = gw * rows_per, cond = cond_of(m0);
            f32x4 s1[4];
#pragma unroll
            for (int j = 0; j < 4; ++j) { const int k = 4 * lane + 256 * j;
                const f32x4 nm = *(const f32x4*)(P.norm_mix + k), sc = *(const f32x4*)(mv + cond * 6 * D + D + k), ba = *(const f32x4*)(P.b_ada + D + k);
                s1[j] = nm * (1.f + sc + ba); }
            for (int i = 0; i < rows_per; ++i) {
                const int m = m0 + i;
                const float* xr = xrow(P, m);
                f32x4 v[4]; float s = 0.f;
#pragma unroll
                for (int j = 0; j < 4; ++j) { v[j] = *(const f32x4*)(xr + 4 * lane + 256 * j); s += (v[j][0] * v[j][0] + v[j][1] * v[j][1]) + (v[j][2] * v[j][2] + v[j][3] * v[j][3]); }
                s = wave_sum(s);
                if (lane == 0) ((float*)(ws + OFF_RSTD1))[m] = rsqrtf(s * (1.f / D) + EPS);
                unsigned long long* o8 = (unsigned long long*)((bf16*)(ws + WS_XB) + (size_t)m * D) + lane;
#pragma unroll
                for (int j = 0; j < 4; ++j) { const f32x4 w = v[j] * s1[j]; o8[64 * j] = (unsigned long long)pk2(w[0], w[1]) | ((unsigned long long)pk2(w[2], w[3]) << 32); }
            }
        }
        constexpr int I_B = (D / 64) * (DIN / 256);
        for (int it = gw; it < 2 * I_B; it += NGW) {
            if (it < I_B) gemv_item<1>(P, P.w_in, DIN, (float*)(ws + OFF_BIAS1), it, lane);
            else gemv_item<2>(P, P.w_up, DIN, (float*)(ws + OFF_BIASUP), it - I_B, lane);
        }
        const int gt = vcu * (NWAVES * 64) + tid;
        if (gt < 3 * D) {
            const int cond = gt >> 10, k = gt & 1023;
            float* prm = (float*)(ws + OFF_PRM) + cond * 6 * D;
            float m6[6];
#pragma unroll
            for (int s = 0; s < 6; ++s) m6[s] = mv[cond * 6 * D + s * D + k] + P.b_ada[s * D + k];
            prm[0 * D + k] = m6[0]; prm[1 * D + k] = P.norm_mix[k] * (1.f + m6[1]); prm[2 * D + k] = m6[2];
            prm[3 * D + k] = m6[3]; prm[4 * D + k] = P.norm_ffn[k] * (1.f + m6[4]); prm[5 * D + k] = m6[5];
        }
    }
    SEAM(1);
    if (IN(2)) {
        pg8::Gemm g{(const pg8::bf16_t*)(ws + WS_XB), (const pg8::bf16_t*)(ws + WS_WIN), M, DIN, D}; pg8::StaticOrder S; S.init(M, DIN, G, bx);
        pg8::EpiG1 E{P};
        pg8::gemm_phase<pg8::EpiG1, pg8::StaticOrder, true, true>(lds, g, S, E);
    }
    SEAM(2);
    if (IN(3)) {
        at::attn_unit(lds, P, 0, vcu >> 3, (vcu >> 2) & 1, (vcu & 3) * 64);
        at::attn_unit(lds, P, 1, vcu >> 7, (vcu >> 6) & 1, (vcu & 63) * 64);
        for (int i = 0; i < 4; ++i) { const int uidx = vcu * 4 + i; at::mix_unit(lds, P, uidx >> 3, uidx & 7); }
    }
    SEAM(3);
    if (IN(4)) {
        pg8::Gemm g{(const pg8::bf16_t*)(ws + WS_AG), (const pg8::bf16_t*)(ws + WS_WCAT), M, D, 2048}; pg8::StaticOrder S; S.init(M, D, G, bx);
        pg8::EpiG3 E{(const pg8::bf16_t*)P.out, (const pg8::bf16_t*)((const unsigned char*)P.out + 32 * MiB), (pg8::bf16_t*)(ws + WS_MRG)};
        pg8::gemm_phase<pg8::EpiG3, pg8::StaticOrder, false, true>(lds, g, S, E);
    }
    SEAM(4);
    if (IN(5)) {
        pg8::Gemm g{(const pg8::bf16_t*)(ws + WS_MRG), (const pg8::bf16_t*)(ws + WS_WOUT), M, D, D}; pg8::StaticOrder S; S.init(M, D, G, bx);
        pg8::EpiRes<0> E{P};
        pg8::gemm_phase<pg8::EpiRes<0>, pg8::StaticOrder, false, true>(lds, g, S, E);
    }
    SEAM(5);
    if (IN(6)) {
        pg8::Gemm g{(const pg8::bf16_t*)(ws + WS_X1B), (const pg8::bf16_t*)(ws + WS_WUP), M, DIN, D}; pg8::StaticOrder S; S.init(M, DIN, G, bx);
        pg8::EpiG5 E{P, (LAS float*)(lds + HALO_OFF)};
        pg8::gemm_phase<pg8::EpiG5, pg8::StaticOrder, true, true>(lds, g, S, E);
    }
    SEAM(6);
    if (IN(7)) {
        const int gt = vcu * (NWAVES * 64) + tid, NGT = G * NWAVES * 64;
        const float* side = (const float*)(ws + WS_SIDE);
        bf16* ACT = (bf16*)(ws + WS_ACT);
        for (int i = gt; i < 30 * 2 * DFF; i += NGT) {
            const int j = i % DFF, rb = i / DFF, q = rb >> 1, which = rb & 1;
            const int tsL = (q / 15) * 16 + (q % 15), tsU = tsL + 1;
            const int ra = (j >> 7) * 256 + (j & 127), rbb = ra + 128, J = DFF + j;
            const float* sL = side + (size_t)tsL * 4 * DIN; const float* sU = side + (size_t)tsU * 4 * DIN;
            const float *r0, *r1, *r2;
            if (which == 0) { r0 = sL + 2 * DIN; r1 = sL + 3 * DIN; r2 = sU; } else { r0 = sL + 3 * DIN; r1 = sU; r2 = sU + DIN; }
            const float a = P.conv_w[j] * r0[ra] + P.conv_w[DIN + j] * r1[ra] + P.conv_w[2 * DIN + j] * r2[ra] + P.conv_b[j];
            const float b = P.conv_w[J] * r0[rbb] + P.conv_w[DIN + J] * r1[rbb] + P.conv_w[2 * DIN + J] * r2[rbb] + P.conv_b[J];
            const int row = (32 + tsU) * 256 - 1 + which;
            ACT[(size_t)row * DFF + j] = (bf16)f2bf(silu_f(a) * b);
        }
    }
    SEAM(7);
    if (IN(8)) {
        pg8::Gemm g{(const pg8::bf16_t*)(ws + WS_ACT), (const pg8::bf16_t*)(ws + WS_WDOWN), M, D, DFF}; pg8::StaticOrder S; S.init(M, D, G, bx);
        pg8::EpiRes<1> E{P};
        pg8::gemm_phase<pg8::EpiRes<1>, pg8::StaticOrder, false, true>(lds, g, S, E);
    }
    SEAM(8);
    if (IN(9)) {
        const int rows_per = M / NGW, m0 = gw * rows_per;
        f32x4 nf[4];
#pragma unroll
        for (int j = 0; j < 4; ++j) nf[j] = *(const f32x4*)(P.norm_final + 4 * lane + 256 * j);
        for (int i = 0; i < rows_per; ++i) {
            const int m = m0 + i;
            const float r = rsqrtf(((const float*)(ws + OFF_SSQ3))[m] * (1.f / D) + EPS);
            float* yr = P.out + (size_t)m * D + 4 * lane;
#pragma unroll
            for (int j = 0; j < 4; ++j) { const f32x4 v = *(const f32x4*)(yr + 256 * j); *(f32x4*)(yr + 256 * j) = v * r * nf[j]; }
        }
    }
#undef IN
#undef SEAM
}
}

#ifndef FASTMASK
#define FASTMASK 0x3ff
#endif
#ifndef ONE_LAUNCH
#define ONE_LAUNCH 1
#endif
static void launch_naive_phase(int k, const L::Ptrs& P, hipStream_t stream) {
    using namespace L;
    unsigned char* ws = P.ws;
    switch (k) {
    case 0:
        nv::n_adaln<<<dim3(6 * D / 256, 3), 256, 0, stream>>>(P);
        nv::n_wconv<1><<<(DIN * D + 255) / 256, 256, 0, stream>>>(P.w_in, D, DIN, (bf16*)(ws + WS_WIN), D, 0, DIN);
        nv::n_wconv<2><<<(DIN * D + 255) / 256, 256, 0, stream>>>(P.w_up, D, DIN, (bf16*)(ws + WS_WUP), D, 0, DIN);
        nv::n_wconv<0><<<(D * D + 255) / 256, 256, 0, stream>>>(P.w_o_attn, D, D, (bf16*)(ws + WS_WCAT), 2048, 0, D);
        nv::n_wconv<0><<<(D * D + 255) / 256, 256, 0, stream>>>(P.w_o_gmlp, D, D, (bf16*)(ws + WS_WCAT), 2048, 1024, D);
        nv::n_wconv<0><<<(D * D + 255) / 256, 256, 0, stream>>>(P.w_out, D, D, (bf16*)(ws + WS_WOUT), D, 0, D);
        nv::n_wconv<0><<<(DFF * D + 255) / 256, 256, 0, stream>>>(P.w_down, DFF, D, (bf16*)(ws + WS_WDOWN), DFF, 0, D);
        nv::n_misc<<<(2 * 256 * 256 + 255) / 256, 256, 0, stream>>>(P);
        break;
    case 1:
        nv::n_prm<<<3 * D / 256, 256, 0, stream>>>(P);
        nv::n_xb<<<M / 4, 256, 0, stream>>>(P);
        nv::n_bias<<<dim3(DIN / 256, 3, 2), 256, 0, stream>>>(P);
        break;
    case 2:
        nv::n_gemm<nv::EpiG1><<<dim3(DIN / 64, M / 64), 256, 0, stream>>>((const bf16*)(ws + WS_XB), D, (const bf16*)(ws + WS_WIN), D, D, nv::EpiG1{P});
        nv::n_rope_scale<<<M, 640, 0, stream>>>(P);
        break;
    case 3:
        nv::n_attn<<<dim3(M, 2), 256, 0, stream>>>(P);
        nv::n_mix<<<dim3(M / 128, 8, 2), 256, 0, stream>>>(P);
        break;
    case 4:
        nv::n_gemm<nv::EpiG3a><<<dim3(D / 64, M / 64), 256, 0, stream>>>((const bf16*)(ws + WS_AG), 2048, (const bf16*)(ws + WS_WCAT), 2048, D, nv::EpiG3a{P});
        nv::n_gemm<nv::EpiG3b><<<dim3(D / 64, M / 64), 256, 0, stream>>>((const bf16*)(ws + WS_AG) + 1024, 2048, (const bf16*)(ws + WS_WCAT) + 1024, 2048, D, nv::EpiG3b{P});
        break;
    case 5:
        nv::n_gemm<nv::EpiG4><<<dim3(D / 64, M / 64), 256, 0, stream>>>((const bf16*)(ws + WS_MRG), D, (const bf16*)(ws + WS_WOUT), D, D, nv::EpiG4{P});
        nv::n_rowssq<<<M / 4, 256, 0, stream>>>((const float*)(ws + WS_X1), (float*)(ws + OFF_SSQ2));
        break;
    case 6: nv::n_g5<<<dim3(DFF / 32, M / 64), 256, 0, stream>>>(P); break;
    case 7: break;
    case 8:
        nv::n_gemm<nv::EpiG6><<<dim3(D / 64, M / 64), 256, 0, stream>>>((const bf16*)(ws + WS_ACT), DFF, (const bf16*)(ws + WS_WDOWN), DFF, DFF, nv::EpiG6{P});
        nv::n_rowssq<<<M / 4, 256, 0, stream>>>((const float*)P.out, (float*)(ws + OFF_SSQ3));
        break;
    case 9: nv::n_final<<<M / 4, 256, 0, stream>>>(P); break;
    }
}
extern "C" void kernel_launch(void* const* d_in, const int* in_sizes, int n_in, void* d_out, int out_size, void* d_ws, size_t ws_size, hipStream_t stream) {
    using namespace L;
    static int ready = 0;
    if (!ready) {
        if (hipFuncSetAttribute((const void*)fr::mega, hipFuncAttributeMaxDynamicSharedMemorySize, fr::LDS_BYTES) != hipSuccess) fprintf(stderr, "kernel_launch: hipFuncSetAttribute failed\n");
        ready = 1;
    }
    fr::Args a{};
    const float** pin = (const float**)&a.P;
    for (int i = 0; i < 23; ++i) pin[i] = (const float*)d_in[i];
    a.P.out = (float*)d_out; a.P.ws = (unsigned char*)d_ws;
    (void)hipMemsetAsync(d_ws, 0, CTL_ZERO, stream);
    if (ONE_LAUNCH) {
        a.lo = 0; a.hi = 10;
        hipLaunchKernelGGL(fr::mega, dim3(256), dim3(512), fr::LDS_BYTES, stream, a);
    } else {
        for (int k = 0; k < 10; ++k) {
            if ((FASTMASK >> k) & 1) { a.lo = k; a.hi = k + 1; hipLaunchKernelGGL(fr::mega, dim3(256), dim3(512), fr::LDS_BYTES, stream, a); }
            else launch_naive_phase(k, a.P, stream);
        }
    }
}
```
